# Optimizing an MI355X kernel written in HIP

```python
import jax, jax.numpy as jnp
from jax import lax
import numpy as np

D_MODEL = 1024
BATCH = 8
SEQ = 2048
DEPTH = 1
DEC_BATCH = 128
DEC_SEQ = 8
PAST_LEN = 16384
PAGE_SIZE = 128

POOL_WIDTH = D_MODEL
POOL_WINDOWS = (2, 4, 8, 16)
N_POOL_GROUPS = len(POOL_WINDOWS)
POOL_GROUP = POOL_WIDTH // N_POOL_GROUPS
POOL_HIST = max(POOL_WINDOWS) - 1
SSD_WIDTH = 2 * D_MODEL
SSD_HEAD_DIM = 64
SSD_HEADS = SSD_WIDTH // SSD_HEAD_DIM
SSD_GROUPS = 4
SSD_HPG = SSD_HEADS // SSD_GROUPS
SSD_STATE = 128
CONV_WIDTH = 4
CONV_DIM = SSD_WIDTH + 2 * SSD_GROUPS * SSD_STATE
SSD_CHUNK = 128
MEM_LEN = 256
ATT_HEADS = 4
ATT_WIDTH = D_MODEL
ATT_HEAD_DIM = ATT_WIDTH // ATT_HEADS
N_BRANCH = 3
EPS = 1e-6
IN_SPLITS = (POOL_WIDTH, POOL_WIDTH, SSD_WIDTH, CONV_DIM, SSD_HEADS, ATT_WIDTH, ATT_WIDTH, N_BRANCH * D_MODEL)
IN_COLS = sum(IN_SPLITS)

kernel_name = 'hybrid_pool_ssd_memattn_decoder_step'


def _rmsnorm(x, w):
    xf = x.astype(jnp.float32)
    y = xf * lax.rsqrt(jnp.mean(xf * xf, axis=-1, keepdims=True) + EPS)
    return (y * w.astype(jnp.float32)).astype(x.dtype)


def _split_points():
    pts, acc = [], 0
    for s in IN_SPLITS[:-1]:
        acc += s
        pts.append(acc)
    return pts


def _pool_mixer(ext, pos0, w_grp, scale):
    b, T, C = ext.shape
    L = T - POOL_HIST
    cs = jnp.cumsum(ext.astype(jnp.float32), axis=1)
    cs0 = jnp.concatenate([jnp.zeros((b, 1, C), jnp.float32), cs], axis=1)
    pos = pos0 + jnp.arange(L)
    outs = []
    for g, w in enumerate(POOL_WINDOWS):
        lo, hi = g * POOL_GROUP, (g + 1) * POOL_GROUP
        win = cs0[:, POOL_HIST + 1:POOL_HIST + 1 + L, lo:hi] - cs0[:, POOL_HIST + 1 - w:POOL_HIST + 1 - w + L, lo:hi]
        cnt = jnp.minimum(w, pos + 1).astype(jnp.float32)
        outs.append(win / cnt[None, :, None])
    pooled = jnp.concatenate(outs, axis=-1)
    u = ext[:, POOL_HIST:]
    d = (pooled - u.astype(jnp.float32)).astype(ext.dtype).reshape(b, L, N_POOL_GROUPS, POOL_GROUP)
    y = jnp.einsum('blgc,gcd->blgd', d, w_grp).reshape(b, L, C)
    return y * scale


def _causal_dwconv(ext, w, bias):
    L = ext.shape[1] - (CONV_WIDTH - 1)
    out = bias
    for k in range(CONV_WIDTH):
        out = out + ext[:, k:k + L] * w[k]
    return out


def _ssd_scan(x, dt, A, B, C, h0):
    b, L, G, R, P = x.shape
    N = B.shape[-1]
    Q = SSD_CHUNK if L % SSD_CHUNK == 0 else L
    nc = L // Q
    xf = x.astype(jnp.float32).reshape(b, nc, Q, G, R, P)
    dtc = dt.reshape(b, nc, Q, G, R)
    Bc = B.astype(jnp.float32).reshape(b, nc, Q, G, N)
    Cc = C.astype(jnp.float32).reshape(b, nc, Q, G, N)
    acs = jnp.cumsum(dtc * A, axis=2)
    acs_t = jnp.moveaxis(acs, 2, -1)
    seg = acs_t[..., :, None] - acs_t[..., None, :]
    mask = jnp.tril(jnp.ones((Q, Q), dtype=bool))
    Lmat = jnp.where(mask, jnp.exp(jnp.where(mask, seg, 0.0)), 0.0)
    xdt = xf * dtc[..., None]
    CB = jnp.einsum('bcqgn,bckgn->bcgqk', Cc, Bc)
    y_diag = jnp.einsum('bcgqk,bcgrqk,bckgrp->bcqgrp', CB, Lmat, xdt)
    decay_out = jnp.exp(acs[:, :, -1:] - acs)
    states = jnp.einsum('bckgn,bckgr,bckgrp->bcgrpn', Bc, decay_out, xdt)
    chunk_decay = jnp.exp(acs[:, :, -1])

    def step(h, inp):
        cd, st = inp
        return h * cd[..., None, None] + st, h

    h_final, h_prev = lax.scan(step, h0.astype(jnp.float32),
                               (jnp.moveaxis(chunk_decay, 1, 0), jnp.moveaxis(states, 1, 0)))
    h_prev = jnp.moveaxis(h_prev, 0, 1)
    y_off = jnp.einsum('bcqgn,bcgrpn,bcqgr->bcqgrp', Cc, h_prev, jnp.exp(acs))
    y = (y_diag + y_off).reshape(b, L, G, R, P)
    return y, h_final.astype(h0.dtype)


def _mem_kv(mem, mem_norm_w, w_mem_k, w_mem_v):
    b, M, _ = mem.shape
    mh = _rmsnorm(mem, mem_norm_w)
    k = jnp.einsum('bmd,de->bme', mh, w_mem_k).reshape(b, M, ATT_HEADS, ATT_HEAD_DIM)
    v = jnp.einsum('bmd,de->bme', mh, w_mem_v).reshape(b, M, ATT_HEADS, ATT_HEAD_DIM)
    return k, v


def _mem_attention(q, k, v):
    b, L, _ = q.shape
    qh = q.reshape(b, L, ATT_HEADS, ATT_HEAD_DIM)
    s = jnp.einsum('blhd,bmhd->bhlm', qh, k).astype(jnp.float32) * (ATT_HEAD_DIM ** -0.5)
    p = jax.nn.softmax(s, axis=-1).astype(v.dtype)
    return jnp.einsum('bhlm,bmhd->blhd', p, v).reshape(b, L, ATT_WIDTH)


def _layer(x, hist_pool, hist_conv, h0, mem_k, mem_v, pos0, norm_w, w_in, w_pool_grp, pool_scale,
           conv_w, conv_b, dt_bias, a_log, d_skip, ssd_norm_w, w_pool_out, w_ssd_out, w_att_out, w_out):
    b, L, _ = x.shape
    h = _rmsnorm(x, norm_w)
    proj = jnp.einsum('bld,de->ble', h, w_in)
    u_pool, z_pool, z_ssd, xbc, dt_raw, q, z_att, gate_logits = jnp.split(proj, _split_points(), axis=-1)
    pool_ext = jnp.concatenate([hist_pool.astype(x.dtype), u_pool], axis=1)
    y_pool = _pool_mixer(pool_ext, pos0, w_pool_grp, pool_scale) * jax.nn.silu(z_pool)
    conv_ext = jnp.concatenate([hist_conv.astype(x.dtype), xbc], axis=1)
    xbc_c = jax.nn.silu(_causal_dwconv(conv_ext, conv_w, conv_b))
    xs, Bm, Cm = jnp.split(xbc_c, [SSD_WIDTH, SSD_WIDTH + SSD_GROUPS * SSD_STATE], axis=-1)
    xs = xs.reshape(b, L, SSD_GROUPS, SSD_HPG, SSD_HEAD_DIM)
    Bm = Bm.reshape(b, L, SSD_GROUPS, SSD_STATE)
    Cm = Cm.reshape(b, L, SSD_GROUPS, SSD_STATE)
    dt = jax.nn.softplus(dt_raw.astype(jnp.float32) + dt_bias.astype(jnp.float32)).reshape(b, L, SSD_GROUPS, SSD_HPG)
    A = -jnp.exp(a_log.astype(jnp.float32)).reshape(SSD_GROUPS, SSD_HPG)
    y_ssm, h_new = _ssd_scan(xs, dt, A, Bm, Cm, h0)
    y_ssm = y_ssm + d_skip.astype(jnp.float32).reshape(SSD_GROUPS, SSD_HPG, 1) * xs.astype(jnp.float32)
    y_ssm = y_ssm.reshape(b, L, SSD_WIDTH).astype(x.dtype)
    y_ssd = _rmsnorm(y_ssm * jax.nn.silu(z_ssd), ssd_norm_w)
    y_att = _mem_attention(q, mem_k, mem_v) * jax.nn.silu(z_att)
    gates = jax.nn.sigmoid(gate_logits.astype(jnp.float32)).astype(x.dtype).reshape(b, L, N_BRANCH, D_MODEL)
    merged = (gates[:, :, 0] * (y_pool @ w_pool_out)
              + gates[:, :, 1] * (y_ssd @ w_ssd_out)
              + gates[:, :, 2] * (y_att @ w_att_out))
    x_out = x + merged @ w_out
    return x_out, pool_ext[:, -POOL_HIST:], conv_ext[:, -(CONV_WIDTH - 1):], h_new


def setup_inputs(seed: int = 0) -> dict:
    key = jax.random.key(seed)
    ks = jax.random.split(key, 32)
    f32 = jnp.float32
    nrm = lambda k, shape, s: jax.random.normal(k, shape, f32) * s
    dt_init = jnp.exp(jax.random.uniform(ks[14], (DEPTH, SSD_HEADS), f32, np.log(1e-3), np.log(1e-1)))
    return {
        'x_prompt': nrm(ks[0], (BATCH, SEQ, D_MODEL), 1.0),
        'x_sample': nrm(ks[1], (DEC_BATCH, DEC_SEQ, D_MODEL), 1.0),
        'mem_prompt': nrm(ks[2], (BATCH, MEM_LEN, D_MODEL), 1.0),
        'state_pool': nrm(ks[3], (DEPTH, DEC_BATCH, POOL_HIST, POOL_WIDTH), 1.0),
        'state_conv': nrm(ks[4], (DEPTH, DEC_BATCH, CONV_WIDTH - 1, CONV_DIM), 1.0),
        'state_ssm': nrm(ks[5], (DEPTH, DEC_BATCH, SSD_GROUPS, SSD_HPG, SSD_HEAD_DIM, SSD_STATE), 0.1),
        'cache_mem_k': nrm(ks[6], (DEPTH, DEC_BATCH, MEM_LEN, ATT_HEADS, ATT_HEAD_DIM), 1.0),
        'cache_mem_v': nrm(ks[7], (DEPTH, DEC_BATCH, MEM_LEN, ATT_HEADS, ATT_HEAD_DIM), 1.0),
        'norm_w': 1.0 + nrm(ks[8], (DEPTH, D_MODEL), 0.02),
        'w_in': nrm(ks[9], (DEPTH, D_MODEL, IN_COLS), D_MODEL ** -0.5),
        'w_pool_grp': nrm(ks[10], (DEPTH, N_POOL_GROUPS, POOL_GROUP, POOL_GROUP), POOL_GROUP ** -0.5),
        'pool_scale': 1.0 + nrm(ks[11], (DEPTH, POOL_WIDTH), 0.1),
        'conv_w': nrm(ks[12], (DEPTH, CONV_WIDTH, CONV_DIM), CONV_WIDTH ** -0.5),
        'conv_b': nrm(ks[13], (DEPTH, CONV_DIM), 0.02),
        'dt_bias': dt_init + jnp.log(-jnp.expm1(-dt_init)),
        'a_log': jnp.log(jax.random.uniform(ks[15], (DEPTH, SSD_HEADS), f32, 1.0, 16.0)),
        'd_skip': 1.0 + nrm(ks[16], (DEPTH, SSD_HEADS), 0.1),
        'ssd_norm_w': 1.0 + nrm(ks[17], (DEPTH, SSD_WIDTH), 0.02),
        'mem_norm_w': 1.0 + nrm(ks[18], (DEPTH, D_MODEL), 0.02),
        'w_mem_k': nrm(ks[19], (DEPTH, D_MODEL, ATT_WIDTH), D_MODEL ** -0.5),
        'w_mem_v': nrm(ks[20], (DEPTH, D_MODEL, ATT_WIDTH), D_MODEL ** -0.5),
        'w_pool_out': nrm(ks[21], (DEPTH, POOL_WIDTH, D_MODEL), POOL_WIDTH ** -0.5),
        'w_ssd_out': nrm(ks[22], (DEPTH, SSD_WIDTH, D_MODEL), SSD_WIDTH ** -0.5),
        'w_att_out': nrm(ks[23], (DEPTH, ATT_WIDTH, D_MODEL), ATT_WIDTH ** -0.5),
        'w_out': nrm(ks[24], (DEPTH, D_MODEL, D_MODEL), D_MODEL ** -0.5),
        'final_norm_w': 1.0 + nrm(ks[25], (D_MODEL,), 0.02),
    }


def reference(x_prompt, x_sample, mem_prompt, state_pool, state_conv, state_ssm, cache_mem_k, cache_mem_v,
              norm_w, w_in, w_pool_grp, pool_scale, conv_w, conv_b, dt_bias, a_log, d_skip, ssd_norm_w,
              mem_norm_w, w_mem_k, w_mem_v, w_pool_out, w_ssd_out, w_att_out, w_out, final_norm_w):
    xp, xs = x_prompt, x_sample
    bp = xp.shape[0]
    pool_p, conv_p, ssm_p, mk_p, mv_p = [], [], [], [], []
    pool_s, conv_s, ssm_s = [], [], []
    for l in range(DEPTH):
        lw = (norm_w[l], w_in[l], w_pool_grp[l], pool_scale[l], conv_w[l], conv_b[l], dt_bias[l], a_log[l],
              d_skip[l], ssd_norm_w[l], w_pool_out[l], w_ssd_out[l], w_att_out[l], w_out[l])
        mk, mv = _mem_kv(mem_prompt, mem_norm_w[l], w_mem_k[l], w_mem_v[l])
        hp0 = jnp.zeros((bp, POOL_HIST, POOL_WIDTH), xp.dtype)
        hc0 = jnp.zeros((bp, CONV_WIDTH - 1, CONV_DIM), xp.dtype)
        hs0 = jnp.zeros((bp, SSD_GROUPS, SSD_HPG, SSD_HEAD_DIM, SSD_STATE), xp.dtype)
        xp, sp, sc, ss = _layer(xp, hp0, hc0, hs0, mk, mv, 0, *lw)
        pool_p.append(sp); conv_p.append(sc); ssm_p.append(ss); mk_p.append(mk); mv_p.append(mv)
        xs, sp, sc, ss = _layer(xs, state_pool[l], state_conv[l], state_ssm[l], cache_mem_k[l], cache_mem_v[l],
                                PAST_LEN, *lw)
        pool_s.append(sp); conv_s.append(sc); ssm_s.append(ss)
    y_prompt = _rmsnorm(xp, final_norm_w)
    y_sample = _rmsnorm(xs, final_norm_w)
    return (y_prompt, y_sample, jnp.stack(pool_p), jnp.stack(conv_p), jnp.stack(ssm_p), jnp.stack(mk_p),
            jnp.stack(mv_p), jnp.stack(pool_s), jnp.stack(conv_s), jnp.stack(ssm_s))
```

```cpp
#include <hip/hip_runtime.h>
#include <hip/hip_cooperative_groups.h>
#include <cstdio>
namespace cg = cooperative_groups;

#define DI __device__ __forceinline__
#define LAS __attribute__((address_space(3)))
typedef unsigned short bf16_t;
typedef short bf16x8 __attribute__((ext_vector_type(8)));
typedef float f32x2 __attribute__((ext_vector_type(2)));
typedef float f32x4 __attribute__((ext_vector_type(4)));
typedef float f32x16 __attribute__((ext_vector_type(16)));
typedef unsigned u32x2 __attribute__((ext_vector_type(2)));
typedef unsigned u32x4 __attribute__((ext_vector_type(4)));
typedef __bf16 bf16x2v __attribute__((ext_vector_type(2)));

constexpr int NTOK = 17408, NPROMPT = 16384;
constexpr int PC = 12288;
constexpr int C_PU = 0, C_PZ = 1024, C_SZ = 2048, C_XBC = 4096, C_Q = 7168, C_AZ = 8192, C_G = 9216;
constexpr int IN_COLS = 12320;
constexpr float EPS = 1e-6f;

constexpr size_t WS_PROJ = 0;
constexpr size_t WS_H    = WS_PROJ + (size_t)NTOK * PC * 2;
constexpr size_t WS_WIN  = WS_H + (size_t)NTOK * 1024 * 2;
constexpr size_t WS_WKV  = WS_WIN + (size_t)PC * 1024 * 2;
constexpr size_t WS_WCAT = WS_WKV + (size_t)2048 * 1024 * 2;
constexpr size_t WS_WO   = WS_WCAT + (size_t)1024 * 4096 * 2;
constexpr size_t WS_WPG  = WS_WO + (size_t)1024 * 1024 * 2;
constexpr size_t WS_MH   = WS_WPG + (size_t)4 * 256 * 256 * 2;
constexpr size_t WS_DT   = WS_MH + (size_t)2048 * 1024 * 2;
constexpr size_t WS_SSQ  = WS_DT + (size_t)NTOK * 32 * 4;
constexpr size_t WS_CTR  = WS_SSQ + (size_t)NTOK * 4;
constexpr size_t WS_PART3 = WS_CTR + 256;
constexpr size_t WS_SSQP = WS_PART3 + (size_t)NTOK * 1024 * 2;
constexpr size_t WS_BAR  = WS_SSQP + (1u << 20);
constexpr size_t WS_SQP2 = WS_SSQP + (size_t)NTOK * 64 * 4;
constexpr size_t WS_END  = WS_SQP2 + (size_t)NPROMPT * 64 * 4;

constexpr size_t O_YP = 0, O_POOLP = 17825792, O_CONVP = 17948672, O_SSMP = 18022400, O_MK = 20119552, O_MV = 22216704,
                 O_POOLS = 24313856, O_CONVS = 26279936, O_SSMS = 27459584;

constexpr int LDS_BYTES = 147456;
constexpr int QSLOT_OFF = LDS_BYTES - 256;
#define ONE_RT (__builtin_amdgcn_readfirstlane(((volatile unsigned*)(p.ws + WS_CTR))[15] == 0u ? 1 : 0))
#define PROBE 0

struct Params { const float* in[26]; float* out; unsigned char* ws; };

DI float bf2f(bf16_t u) { return __uint_as_float(((unsigned)u) << 16); }
DI unsigned pack_bf2(float lo, float hi) { f32x2 v = {lo, hi}; bf16x2v b = __builtin_convertvector(v, bf16x2v); return __builtin_bit_cast(unsigned, b); }
DI bf16_t f2bf(float x) { return (bf16_t)(pack_bf2(x, 0.f) & 0xffffu); }
DI float silu_f(float x) { return x * __builtin_amdgcn_rcpf(1.f + __expf(-x)); }
DI float sigmoid_f(float x) { return __builtin_amdgcn_rcpf(1.f + __expf(-x)); }
DI int tid_opaque(int wid_s) { int t = wid_s * 64 + (int)__builtin_amdgcn_mbcnt_hi(~0u, __builtin_amdgcn_mbcnt_lo(~0u, 0u)); asm volatile("" : "+v"(t)); return t; }
DI void lds_barrier() { asm volatile("s_waitcnt lgkmcnt(0)" ::: "memory"); __builtin_amdgcn_s_barrier(); asm volatile("" ::: "memory"); }
DI float dpp_add_x1(float v) { return v + __builtin_bit_cast(float, __builtin_amdgcn_update_dpp(0, __builtin_bit_cast(int, v), 0xB1, 0xf, 0xf, false)); }
DI float dpp_add_x2(float v) { return v + __builtin_bit_cast(float, __builtin_amdgcn_update_dpp(0, __builtin_bit_cast(int, v), 0x4E, 0xf, 0xf, false)); }
DI float dpp_add_hm(float v) { return v + __builtin_bit_cast(float, __builtin_amdgcn_update_dpp(0, __builtin_bit_cast(int, v), 0x141, 0xf, 0xf, false)); }
DI float xchg32(float v, bool upper) { const unsigned u = __builtin_bit_cast(unsigned, v); auto r = __builtin_amdgcn_permlane32_swap(u, u, false, false); return __builtin_bit_cast(float, upper ? r[0] : r[1]); }
DI float xchg16(float v, bool odd) { const unsigned u = __builtin_bit_cast(unsigned, v); auto r = __builtin_amdgcn_permlane16_swap(u, u, false, false); return __builtin_bit_cast(float, odd ? r[0] : r[1]); }
DI float xchg8(float v) { return __builtin_bit_cast(float, __builtin_amdgcn_update_dpp(0, __builtin_bit_cast(int, v), 0x128, 0xf, 0xf, false)); }
DI float xchg_hm(float v) { return __builtin_bit_cast(float, __builtin_amdgcn_update_dpp(0, __builtin_bit_cast(int, v), 0x141, 0xf, 0xf, false)); }
DI int crow(int reg, int h) { return (reg & 3) + 8 * (reg >> 2) + 4 * h; }
#define MFMA32(a, b, c) __builtin_amdgcn_mfma_f32_32x32x16_bf16((a), (b), (c), 0, 0, 0)
DI const float* xrow(const Params& p, int row) { return row < NPROMPT ? p.in[0] + (size_t)row * 1024 : p.in[1] + (size_t)(row - NPROMPT) * 1024; }


#define XB_TMO      128
#define XB_XCNT(j)  (256  + 64 * (j))
#define XB_XSUB(j)  (1280 + 64 * (j))
#define XB_XGEN(j)  (2304 + 64 * (j))
#define XB_TOP      3328
#define XB_TOPGEN   3392
#define XCD_BAR_WORDS 3456
#define XB_SPIN_CAP (1u << 18)
DI unsigned xb_ld(unsigned* p)              { return __hip_atomic_load(p, __ATOMIC_RELAXED, __HIP_MEMORY_SCOPE_AGENT); }
DI unsigned xb_add(unsigned* p, unsigned v) { return __hip_atomic_fetch_add(p, v, __ATOMIC_RELAXED, __HIP_MEMORY_SCOPE_AGENT); }
DI unsigned xb_xcc_id() { return (unsigned)__builtin_amdgcn_s_getreg((3 << 11) | 20) & 0xFu; }
#define XB_SPIN(cond, bar) do { unsigned _sp = 0; while (cond) { __builtin_amdgcn_s_sleep(1); \
    if ((++_sp & 255u) == 0u) { if (xb_ld(&(bar)[XB_TMO])) break; if (_sp > XB_SPIN_CAP) { atomicAdd(&(bar)[XB_TMO], 1u); break; } } } } while (0)
struct XcdBarrier { unsigned* bar; unsigned x; volatile LAS unsigned* st; };
DI XcdBarrier xcd_barrier_post(unsigned* bar, volatile LAS unsigned* st, int wid_s) {
    XcdBarrier b; b.bar = bar; b.x = xb_xcc_id(); b.st = st;
    if (tid_opaque(wid_s) == 0) (void)xb_add(&bar[XB_XCNT(b.x)], 1u);
    return b;
}
DI void xcd_barrier_complete(unsigned* bar, unsigned x, unsigned& nloc, unsigned& nx) {
    const unsigned G = gridDim.x * gridDim.y * gridDim.z;
    unsigned sum, cnt, mine, sp = 0u;
    for (;;) {
        sum = 0u; cnt = 0u; mine = 0u;
#pragma unroll
        for (unsigned j = 0; j < 16; ++j) { const unsigned c = xb_ld(&bar[XB_XCNT(j)]); sum += c; cnt += (c > 0u) ? 1u : 0u; mine = (j == x) ? c : mine; }
        if (sum == G) break;
        __builtin_amdgcn_s_sleep(1);
        if ((++sp & 255u) == 0u) { if (xb_ld(&bar[XB_TMO])) break; if (sp > XB_SPIN_CAP) { atomicAdd(&bar[XB_TMO], 1u); break; } }
    }
    nloc = mine > 0u ? mine : 1u; nx = cnt > 0u ? cnt : 1u;
}
DI void xcd_barrier(const XcdBarrier& b, int wid_s) {
    asm volatile("s_waitcnt vmcnt(0)" ::: "memory");
    __syncthreads();
    if (tid_opaque(wid_s) == 0) {
        unsigned* bar = b.bar;
        __builtin_amdgcn_s_waitcnt(0);
        unsigned nloc = b.st[0], nx = b.st[1];
        if (nloc == 0u) { xcd_barrier_complete(bar, b.x, nloc, nx); b.st[0] = nloc; b.st[1] = nx; }
        const unsigned old = xb_add(&bar[XB_XSUB(b.x)], 1u);
        const unsigned gen = old / nloc;
        if (old + 1u == (gen + 1u) * nloc) {
            __builtin_amdgcn_fence(__ATOMIC_RELEASE, "agent");
            asm volatile("s_waitcnt vmcnt(0)" ::: "memory");
            const unsigned og = xb_add(&bar[XB_TOP], 1u);
            const unsigned tg = og / nx;
            if (og + 1u == (tg + 1u) * nx) xb_add(&bar[XB_TOPGEN], 1u);
            else XB_SPIN(xb_ld(&bar[XB_TOPGEN]) == tg, bar);
            __builtin_amdgcn_fence(__ATOMIC_ACQUIRE, "agent");
            xb_add(&bar[XB_XGEN(b.x)], 1u);
            asm volatile("s_waitcnt vmcnt(0)" ::: "memory");
        } else {
            XB_SPIN(xb_ld(&bar[XB_XGEN(b.x)]) == gen, bar);
            __builtin_amdgcn_fence(__ATOMIC_ACQUIRE, "agent");
            asm volatile("s_waitcnt vmcnt(0)" ::: "memory");
        }
    }
    __syncthreads();
}

constexpr int BM = 256, BK = 64, HALF = 128, HTB = HALF * BK * 2;
DI int lds_byte(int r, int c) { const int st = (r >> 4) * 2 + (c >> 5), rr = r & 15, cc = c & 31, ob = rr * 64 + cc * 2; return st * 1024 + (ob ^ (((ob >> 9) & 1) << 5)); }
DI void stage_rc(int b, int& R, int& C) { const int st = b / 1024, sb = b % 1024, swz = sb ^ (((sb >> 9) & 1) << 5); R = (st >> 1) * 16 + swz / 64; C = (st & 1) * 32 + (swz % 64) / 2; }
DI int perm32(int rho) { const int n = rho >> 4, i = rho & 15; return 8 * (i >> 2) + 4 * n + (i & 3); }
struct GUnit { const char* a; const char* b; int pm, pn, aux, nt; };

template <class Sched, class Epi>
DI void gemm_phase(LAS unsigned char* lds, const int K, const int lda, const int ldb, const Sched& S, const Epi& E, const int wid_s) {
    int tid_ = tid_opaque(wid_s);
    const int tid = tid_, wid = __builtin_amdgcn_readfirstlane(tid >> 6), lane = tid & 63, wr = wid >> 2, wc = wid & 3, fr = lane & 15, fq = lane >> 4;
    unsigned voffA[2], voffB[2];
#pragma unroll
    for (int i = 0; i < 2; ++i) { int R, C; stage_rc(tid * 16 + i * 8192, R, C); const int Rb = (R & ~31) + perm32(R & 31);
        voffA[i] = (unsigned)(R * lda + C) * 2u; voffB[i] = (unsigned)(Rb * ldb + C) * 2u; }
    const size_t kstep = (size_t)(BK * 2);
    const size_t hstepA = (size_t)HALF * lda * 2, hstepB = (size_t)HALF * ldb * 2;
    const unsigned ldsw = (unsigned)wid * 1024u;
    const int aoff = lds_byte(wr * 64 + fr, fq * 8), boff = lds_byte(wc * 32 + fr, fq * 8);
#define PG8_SA(b, h) (((b) * 2 + (h)) * HTB)
#define PG8_SB(b, h) ((4 + (b) * 2 + (h)) * HTB)
#define PG8_STAGE(bufoff, gbase, voff) do { _Pragma("unroll") for (int _i = 0; _i < 2; ++_i) \
        __builtin_amdgcn_global_load_lds((const unsigned*)((const char*)(gbase) + (voff)[_i]), (LAS unsigned*)(lds + (bufoff) + ldsw + _i * 8192), 16, 0, 0); } while (0)
#define PG8_LDA(dst, b, h) do { _Pragma("unroll") for (int m = 0; m < 4; ++m) _Pragma("unroll") for (int k = 0; k < 2; ++k) dst[m][k] = *(const LAS bf16x8*)(lds + PG8_SA(b, h) + aoff + m * 2048 + k * 1024); } while (0)
#define PG8_LDB(dst, b, h) do { _Pragma("unroll") for (int n = 0; n < 2; ++n) _Pragma("unroll") for (int k = 0; k < 2; ++k) dst[n][k] = *(const LAS bf16x8*)(lds + PG8_SB(b, h) + boff + n * 2048 + k * 1024); } while (0)
#define PG8_MMA(ai, bj, At, Bt) do { __builtin_amdgcn_s_setprio(1); _Pragma("unroll") for (int m = 0; m < 4; ++m) _Pragma("unroll") for (int n = 0; n < 2; ++n) _Pragma("unroll") for (int k = 0; k < 2; ++k) \
        acc[ai][bj][m][n] = __builtin_amdgcn_mfma_f32_16x16x32_bf16(Bt[n][k], At[m][k], acc[ai][bj][m][n], 0, 0, 0); __builtin_amdgcn_s_setprio(0); } while (0)
#define PG8_WAIT_V(n) asm volatile("s_waitcnt vmcnt(" #n ")" ::: "memory")
#define PG8_WAIT_L(n) asm volatile("s_waitcnt lgkmcnt(" #n ")" ::: "memory")
#define PG8_BAR __builtin_amdgcn_s_barrier()
#define PG8_SCHED __builtin_amdgcn_sched_barrier(0)
    GUnit cur, nxt; int ui = 0;
    if (!S.next(0, cur)) return;
    f32x4 acc[2][2][4][2];
#pragma unroll
    for (int a = 0; a < 2; ++a)
#pragma unroll
        for (int b = 0; b < 2; ++b)
#pragma unroll
            for (int m = 0; m < 4; ++m)
#pragma unroll
                for (int n = 0; n < 2; ++n) acc[a][b][m][n] = (f32x4){0.f, 0.f, 0.f, 0.f};
    bf16x8 At[4][2], B0[2][2], B1[2][2];
    const char* cA = cur.a; const char* cB = cur.b;
    PG8_STAGE(PG8_SB(0, 0), cB, voffB); PG8_STAGE(PG8_SA(0, 0), cA, voffA); PG8_STAGE(PG8_SB(0, 1), cB + hstepB, voffB); PG8_STAGE(PG8_SA(0, 1), cA + hstepA, voffA);
    if (wr == 1) PG8_BAR;
    PG8_WAIT_V(4); PG8_BAR;
    PG8_STAGE(PG8_SB(1, 0), cB + kstep, voffB); PG8_STAGE(PG8_SA(1, 0), cA + kstep, voffA); PG8_STAGE(PG8_SB(1, 1), cB + hstepB + kstep, voffB);
    PG8_WAIT_V(6); PG8_BAR;
    for (;;) {
        const bool has_next = S.next(ui + 1, nxt);
        const char* nA = has_next ? nxt.a : cA; const char* nB = has_next ? nxt.b : cB;
        const int nt = cur.nt;
        for (int t = 0; t < nt; t += 2) {
            const bool last = (t == nt - 2);
            const char* a1 = cA + (size_t)(t + 1) * kstep;
            const char* a2 = last ? nA : cA + (size_t)(t + 2) * kstep; const char* b2 = last ? nB : cB + (size_t)(t + 2) * kstep;
            const char* a3 = a2 + kstep; const char* b3 = b2 + kstep;
            PG8_LDB(B0, 0, 0); PG8_SCHED; PG8_LDA(At, 0, 0); PG8_STAGE(PG8_SA(1, 1), a1 + hstepA, voffA);
            PG8_WAIT_L(8); PG8_BAR; PG8_WAIT_L(0); PG8_MMA(0, 0, At, B0); PG8_BAR; PG8_SCHED;
            PG8_LDB(B1, 0, 1); PG8_STAGE(PG8_SB(0, 0), b2, voffB);
            PG8_BAR; PG8_WAIT_L(0); PG8_MMA(0, 1, At, B1); PG8_BAR;
            PG8_LDA(At, 0, 1); PG8_STAGE(PG8_SA(0, 0), a2, voffA);
            PG8_BAR; PG8_WAIT_L(0); PG8_MMA(1, 0, At, B0); PG8_BAR; PG8_SCHED;
            PG8_STAGE(PG8_SB(0, 1), b2 + hstepB, voffB);
            PG8_WAIT_V(6); PG8_BAR; PG8_MMA(1, 1, At, B1); PG8_BAR;
            PG8_LDB(B0, 1, 0); PG8_SCHED; PG8_LDA(At, 1, 0); PG8_STAGE(PG8_SA(0, 1), a2 + hstepA, voffA);
            PG8_WAIT_L(8); PG8_BAR; PG8_WAIT_L(0); PG8_MMA(0, 0, At, B0); PG8_BAR; PG8_SCHED;
            PG8_LDB(B1, 1, 1); PG8_STAGE(PG8_SB(1, 0), b3, voffB);
            PG8_BAR; PG8_WAIT_L(0); PG8_MMA(0, 1, At, B1); PG8_BAR;
            PG8_LDA(At, 1, 1); PG8_STAGE(PG8_SA(1, 0), a3, voffA);
            PG8_BAR; PG8_WAIT_L(0); PG8_MMA(1, 0, At, B0); PG8_BAR; PG8_SCHED;
            PG8_STAGE(PG8_SB(1, 1), b3 + hstepB, voffB);
            PG8_WAIT_V(6); PG8_BAR; PG8_MMA(1, 1, At, B1); PG8_BAR;
        }
        E(acc, cur, wr, wc, fr, fq);
        if (!has_next) break;
#pragma unroll
        for (int a = 0; a < 2; ++a)
#pragma unroll
            for (int b = 0; b < 2; ++b)
#pragma unroll
                for (int m = 0; m < 4; ++m)
#pragma unroll
                    for (int n = 0; n < 2; ++n) acc[a][b][m][n] = (f32x4){0.f, 0.f, 0.f, 0.f};
        cur = nxt; cA = nA; cB = nB; ++ui;
    }
    PG8_WAIT_V(0);
    if (wr == 0) PG8_BAR;
    PG8_BAR;
#undef PG8_SA
#undef PG8_SB
#undef PG8_STAGE
#undef PG8_LDA
#undef PG8_LDB
#undef PG8_MMA
#undef PG8_WAIT_V
#undef PG8_WAIT_L
#undef PG8_BAR
#undef PG8_SCHED
}

struct SchedP1 {
    const char* h; const char* win; const char* mh; const char* wkv; int G, c;
    DI bool next(int i, GUnit& u) const {
        const int L = i * G + c;
        if (L >= 3328) return false;
        if (L < 3264) {
            const int nM = 68, nN = 48, nwg = 3264; int wgid = L;
            { const int q = nwg / 8, r = nwg % 8, xcd = wgid % 8, off = wgid / 8; wgid = (xcd < r ? xcd * (q + 1) : r * (q + 1) + (xcd - r) * q) + off; }
            const int nig = 8 * nN, gid = wgid / nig, fm = gid * 8, gsz = (nM - fm) < 8 ? (nM - fm) : 8;
            u.pm = fm + ((wgid % nig) % gsz); u.pn = (wgid % nig) / gsz; u.aux = 0; u.nt = 16;
            u.a = h + (size_t)u.pm * 256 * 1024 * 2; u.b = win + (size_t)u.pn * 256 * 1024 * 2;
        } else {
            const int idx = L - 3264; u.pm = idx >> 3; u.pn = idx & 7; u.aux = 1; u.nt = 16;
            u.a = mh + (size_t)u.pm * 256 * 1024 * 2; u.b = wkv + (size_t)u.pn * 256 * 1024 * 2;
        }
        return true;
    }
};
struct SchedP3 {
    const char* proj; const char* wcat; int G, c;
    DI bool next(int i, GUnit& u) const {
        const int L = i * G + c;
        if (L >= 1088) return false;
        const int part = L / 272, tile = L % 272; u.pm = tile % 68; u.pn = tile / 68; u.aux = part; u.nt = 16;
        const int acol = part == 0 ? C_PZ : (part == 1 ? C_SZ : (part == 2 ? C_SZ + 1024 : C_Q));
        u.a = proj + ((size_t)u.pm * 256 * PC + acol) * 2; u.b = wcat + ((size_t)u.pn * 256 * 4096 + part * 1024) * 2;
        return true;
    }
};
struct SchedP4 {
    const char* mg; const char* wo; int G, c;
    DI bool next(int i, GUnit& u) const {
        const int L = i * G + c;
        if (L >= 320) return false;
        if (L < 256) { u.pm = L % 68; u.pn = L / 68; u.aux = 0; u.nt = 16;
            u.a = mg + ((size_t)u.pm * 256 * 1024) * 2; u.b = wo + ((size_t)u.pn * 256 * 1024) * 2; }
        else { const int q = L - 256, tile = 256 + (q >> 2), kq = q & 3; u.pm = tile % 68; u.pn = tile / 68; u.aux = kq; u.nt = 4;
            u.a = mg + ((size_t)u.pm * 256 * 1024 + kq * 256) * 2; u.b = wo + ((size_t)u.pn * 256 * 1024 + kq * 256) * 2; }
        return true;
    }
};

struct EpiP1 {
    bf16_t* proj; float* out;
    DI void operator()(const f32x4 (&acc)[2][2][4][2], const GUnit& u, int wr, int wc, int fr, int fq) const {
        const int row0 = u.pm * 256 + wr * 64 + fr, col0 = u.pn * 256 + wc * 32 + 8 * fq;
        if (u.aux == 0) {
            const int cb = u.pn * 256;
            const int act = (cb >= C_G) ? 0 : (((cb >= C_PZ && cb < C_XBC) || (cb >= C_AZ)) ? 1 : 0);
#pragma unroll
            for (int ai = 0; ai < 2; ++ai)
#pragma unroll
                for (int m = 0; m < 4; ++m) { bf16_t* rowp = proj + (size_t)(row0 + ai * HALF + m * 16) * PC + col0;
#pragma unroll
                    for (int bj = 0; bj < 2; ++bj) { f32x4 v0 = acc[ai][bj][m][0], v1 = acc[ai][bj][m][1];
                        if (act == 1) {
#pragma unroll
                            for (int j = 0; j < 4; ++j) { v0[j] = silu_f(v0[j]); v1[j] = silu_f(v1[j]); } }
                        else if (act == 2) {
#pragma unroll
                            for (int j = 0; j < 4; ++j) { v0[j] = sigmoid_f(v0[j]); v1[j] = sigmoid_f(v1[j]); } }
                        u32x4 w; w.x = pack_bf2(v0[0], v0[1]); w.y = pack_bf2(v0[2], v0[3]); w.z = pack_bf2(v1[0], v1[1]); w.w = pack_bf2(v1[2], v1[3]);
                        __builtin_nontemporal_store(w, (u32x4*)(rowp + bj * HALF)); } }
        } else {
            float* base = out + (col0 < 1024 ? O_MK : O_MV); const int c = col0 & 1023;
#pragma unroll
            for (int ai = 0; ai < 2; ++ai)
#pragma unroll
                for (int m = 0; m < 4; ++m) { float* rowp = base + (size_t)(row0 + ai * HALF + m * 16) * 1024 + c;
#pragma unroll
                    for (int bj = 0; bj < 2; ++bj) { *(f32x4*)(rowp + bj * HALF) = acc[ai][bj][m][0]; *(f32x4*)(rowp + bj * HALF + 4) = acc[ai][bj][m][1]; } }
        }
    }
};
struct EpiP3 {
    bf16_t* part[4];
    DI void operator()(const f32x4 (&acc)[2][2][4][2], const GUnit& u, int wr, int wc, int fr, int fq) const {
        const int row0 = u.pm * 256 + wr * 64 + fr, col0 = u.pn * 256 + wc * 32 + 8 * fq;
        bf16_t* base = u.aux == 0 ? part[0] : (u.aux == 1 ? part[1] : (u.aux == 2 ? part[2] : part[3]));
#pragma unroll
        for (int ai = 0; ai < 2; ++ai)
#pragma unroll
            for (int m = 0; m < 4; ++m) { bf16_t* rowp = base + (size_t)(row0 + ai * HALF + m * 16) * 1024 + col0;
#pragma unroll
                for (int bj = 0; bj < 2; ++bj) { const f32x4 v0 = acc[ai][bj][m][0], v1 = acc[ai][bj][m][1];
                    u32x4 w; w.x = pack_bf2(v0[0], v0[1]); w.y = pack_bf2(v0[2], v0[3]); w.z = pack_bf2(v1[0], v1[1]); w.w = pack_bf2(v1[2], v1[3]);
                    *(u32x4*)(rowp + bj * HALF) = w; } }
    }
};
struct EpiP4 {
    float* out; const float* xp; const float* xs; float* partq;
    DI void operator()(const f32x4 (&acc)[2][2][4][2], const GUnit& u, int wr, int wc, int fr, int fq) const {
        const int row0 = u.pm * 256 + wr * 64 + fr, col0 = u.pn * 256 + wc * 32 + 8 * fq;
#pragma unroll
        for (int ai = 0; ai < 2; ++ai)
#pragma unroll
            for (int m = 0; m < 4; ++m) { const int row = row0 + ai * HALF + m * 16;
                if (u.aux == 0) {
                    const float* xr = (row < NPROMPT ? xp + (size_t)row * 1024 : xs + (size_t)(row - NPROMPT) * 1024) + col0;
                    float* o = out + (size_t)row * 1024 + col0;
#pragma unroll
                    for (int bj = 0; bj < 2; ++bj) { *(f32x4*)(o + bj * HALF) = __builtin_nontemporal_load((const f32x4*)(xr + bj * HALF)) + acc[ai][bj][m][0]; *(f32x4*)(o + bj * HALF + 4) = __builtin_nontemporal_load((const f32x4*)(xr + bj * HALF + 4)) + acc[ai][bj][m][1]; }
                } else {
                    float* o = partq + ((size_t)(u.aux - 1) * 4096 + (row - 13312)) * 256 + (col0 - 768);
#pragma unroll
                    for (int bj = 0; bj < 2; ++bj) { *(f32x4*)(o + bj * HALF) = acc[ai][bj][m][0]; *(f32x4*)(o + bj * HALF + 4) = acc[ai][bj][m][1]; }
                } }
    }
};

DI bf16x8 tr_frag(const bf16_t* arr, int stride_elems, int k0, int c0, int lane) {
    const int h = lane >> 5, blk = (lane >> 4) & 1, q = (lane & 15) >> 2, pp = lane & 3;
    const unsigned a0 = (unsigned)(size_t)(arr + (k0 + 8 * h + q) * stride_elems + c0 + 16 * blk + 4 * pp);
    const unsigned a1 = a0 + 4u * (unsigned)stride_elems * 2u;
    u32x2 lo, hi;
    asm volatile("ds_read_b64_tr_b16 %0, %2\n\tds_read_b64_tr_b16 %1, %3\n\ts_waitcnt lgkmcnt(0)" : "=&v"(lo), "=&v"(hi) : "v"(a0), "v"(a1) : "memory");
    u32x4 w; w.x = lo.x; w.y = lo.y; w.z = hi.x; w.w = hi.y;
    return __builtin_bit_cast(bf16x8, w);
}
DI void tr_tile_wave(const float* src, int srcld, int srccol0, int k0, bf16_t* dst, int dstld, const float* kscale, float mul, bf16_t* tl, int lane) {
    const int kq = lane >> 4, n4 = (lane & 15) * 4;
    f32x4 v[16];
#pragma unroll
    for (int it = 0; it < 16; ++it) v[it] = __builtin_nontemporal_load((const f32x4*)(src + (size_t)(k0 + it * 4 + kq) * srcld + srccol0 + n4));
#pragma unroll
    for (int it = 0; it < 16; ++it) { const int k = it * 4 + kq; const float sc = (kscale ? kscale[k0 + k] : 1.0f) * mul;
        u32x2 w; w.x = pack_bf2(v[it][0] * sc, v[it][1] * sc); w.y = pack_bf2(v[it][2] * sc, v[it][3] * sc);
        *(u32x2*)(tl + k * 72 + n4) = w; }
    asm volatile("s_waitcnt lgkmcnt(0)" ::: "memory");
    const int r = lane & 31, h = lane >> 5;
#pragma unroll
    for (int c = 0; c < 2; ++c)
#pragma unroll
        for (int ks = 0; ks < 4; ++ks) { const bf16x8 f = tr_frag(tl, 72, ks * 16, c * 32, lane);
            *(bf16x8*)(dst + (size_t)(c * 32 + r) * dstld + k0 + ks * 16 + 8 * h) = f; }
}

DI void phase0(const Params& p, unsigned char* lds, const int wid_s) {
    const int tid = tid_opaque(wid_s), wid = tid >> 6, lane = tid & 63, G = gridDim.x, bid = blockIdx.x;
    unsigned char* ws = p.ws;
    if (bid == 0 && tid < 16) ((unsigned*)(ws + WS_CTR))[tid] = 0u;
    const int rank = wid * G + bid, NWK = 8 * G;
    bf16_t* tl = (bf16_t*)(lds + wid * 9216);
    for (int t = rank; t < 4944; t += NWK) {
        if (t >= 4928) { const int kt = t - 4928;
            tr_tile_wave(p.in[9], IN_COLS, 7168, kt * 64, (bf16_t*)(ws + WS_SSQP), 1024, nullptr, 1.0f, tl, lane); }
        else if (t < 3072) { const int nt_ = t >> 4, kt = t & 15; const int n0 = nt_ * 64; const int sc0 = n0 < C_Q ? n0 : n0 + 32;
            tr_tile_wave(p.in[9], IN_COLS, sc0, kt * 64, (bf16_t*)(ws + WS_WIN) + (size_t)n0 * 1024, 1024, nullptr, (n0 >= C_Q && n0 < C_AZ) ? 0.0625f : 1.0f, tl, lane); }
        else if (t < 3584) { const int u = t - 3072; const int nt_ = u >> 4, kt = u & 15; const int n0 = nt_ * 64;
            tr_tile_wave(n0 < 1024 ? p.in[19] : p.in[20], 1024, n0 & 1023, kt * 64, (bf16_t*)(ws + WS_WKV) + (size_t)n0 * 1024, 1024, nullptr, 1.0f, tl, lane); }
        else if (t < 4608) { const int u = t - 3584; const int nt_ = u >> 6, kt = u & 63; const int n0 = nt_ * 64, k0 = kt * 64;
            bf16_t* dst = (bf16_t*)(ws + WS_WCAT) + (size_t)n0 * 4096;
            if (k0 < 1024) tr_tile_wave(p.in[21], 1024, n0, k0, dst, 4096, nullptr, 1.0f, tl, lane);
            else if (k0 < 3072) tr_tile_wave(p.in[22], 1024, n0, k0 - 1024, dst + 1024, 4096, p.in[17], 1.0f, tl, lane);
            else tr_tile_wave(p.in[23], 1024, n0, k0 - 3072, dst + 3072, 4096, nullptr, 1.0f, tl, lane); }
        else if (t < 4864) { const int u = t - 4608; const int nt_ = u >> 4, kt = u & 15;
            tr_tile_wave(p.in[24], 1024, nt_ * 64, kt * 64, (bf16_t*)(ws + WS_WO) + (size_t)nt_ * 64 * 1024, 1024, nullptr, 1.0f, tl, lane); }
        else { const int u = t - 4864; const int g = u >> 4, nt_ = (u >> 2) & 3, kt = u & 3;
            tr_tile_wave(p.in[10] + (size_t)g * 65536, 256, nt_ * 64, kt * 64, (bf16_t*)(ws + WS_WPG) + (size_t)g * 65536 + (size_t)nt_ * 64 * 256, 256, nullptr, 1.0f, tl, lane); }
    }
    for (int row = rank; row < NTOK + 2048; row += NWK) {
        const float* src; const float* w; bf16_t* dst;
        if (row < NTOK) { src = xrow(p, row); w = p.in[8]; dst = (bf16_t*)(ws + WS_H) + (size_t)row * 1024; }
        else { src = p.in[2] + (size_t)(row - NTOK) * 1024; w = p.in[18]; dst = (bf16_t*)(ws + WS_MH) + (size_t)(row - NTOK) * 1024; }
        f32x4 v[4]; float ss = 0.f;
#pragma unroll
        for (int j = 0; j < 4; ++j) { v[j] = __builtin_nontemporal_load((const f32x4*)(src + j * 256 + lane * 4)); ss += v[j][0] * v[j][0] + v[j][1] * v[j][1] + v[j][2] * v[j][2] + v[j][3] * v[j][3]; }
#pragma unroll
        for (int o = 32; o > 0; o >>= 1) ss += __shfl_xor(ss, o);
        const float rs = rsqrtf(ss * (1.0f / 1024.0f) + EPS);
#pragma unroll
        for (int j = 0; j < 4; ++j) { const f32x4 wv = *(const f32x4*)(w + j * 256 + lane * 4);
            u32x2 o2; o2.x = pack_bf2(v[j][0] * rs * wv[0], v[j][1] * rs * wv[1]); o2.y = pack_bf2(v[j][2] * rs * wv[2], v[j][3] * rs * wv[3]);
            *(u32x2*)(dst + j * 256 + lane * 4) = o2; }
    }
}

#define SSD_DRY (PROBE == 3 && ((volatile int*)(lds + QSLOT_OFF))[1] != 0)
#define SSD_LVL ((PROBE == 3) ? ((volatile int*)(lds + QSLOT_OFF))[1] : 0)
#ifndef PROBE_LVL
#define PROBE_LVL 1
#endif
DI void ssd_prompt_item(const Params& p, unsigned char* lds, int item, const int wid_s) {
    const int tid = tid_opaque(wid_s), wid = tid >> 6, lane = tid & 63, r = lane & 31, hh = lane >> 5;
    const int b = item >> 5, head = item & 31, g = head >> 3;
    bf16_t* proj = (bf16_t*)(p.ws + WS_PROJ);
    const bf16_t* bcb = (const bf16_t*)(p.ws + WS_PART3);
    const float* dtbuf = (const float*)(p.ws + WS_DT);
    const float Ah = -__expf(p.in[15][head]);
    const float Dh = p.in[16][head];
    const float* convw = p.in[12]; const float* convb = p.in[13];
    bf16_t* Cs = (bf16_t*)lds;
    bf16_t* Bs = Cs + 128 * 136;
    bf16_t* Ms = Bs + 128 * 136;
    bf16_t* xs = Ms + 128 * 136;
    bf16_t* hb = xs + 128 * 72;
    float* acs = (float*)(hb + 64 * 136);
    float* wk = acs + 128; float* dtv = wk + 128; float* eacs = dtv + 128; float* cw = eacs + 128;
    f32x16 hacc; for (int i = 0; i < 16; ++i) hacc[i] = 0.f;
    const int pt = wid >> 2, ntl = wid & 3;
    const int qt = wid >> 1, t2 = wid & 1;
    const int j0 = wid, j1 = 8 + wid;
    const int gq0 = j0 < 1 ? 0 : (j0 < 3 ? 1 : (j0 < 6 ? 2 : 3)), gk0 = j0 - gq0 * (gq0 + 1) / 2;
    const int gq1 = 3, gk1 = j1 - 6;
    const bool two = wid < 2;
    const int xpair = tid & 31, xseg = tid >> 5;
    const int xch = head * 64 + 2 * xpair;
    if (tid < 64) {
#pragma unroll
        for (int k = 0; k < 4; ++k) cw[k * 64 + tid] = convw[k * 3072 + head * 64 + tid];
        cw[4 * 64 + tid] = convb[head * 64 + tid]; }
    const unsigned roff0 = (unsigned)(b * 2048 + xseg * 8 - 3) * PC + C_XBC + xch;
    const unsigned boff0 = (unsigned)(b * 2048 + (tid >> 5)) * 1024 + g * 128 + ((tid & 31) >> 4) * 512 + (tid & 15) * 8;
    const unsigned zoff0 = (unsigned)(b * 2048 + qt * 32 + r) * PC + C_SZ + head * 64 + t2 * 32 + 4 * hh;
    unsigned raw[11]; u32x4 bcv[8]; u32x2 zr[4]; float dtc0 = 0.f, dtc1 = 0.f;
#pragma unroll
    for (int i = 0; i < 11; ++i) { const int t = xseg * 8 - 3 + i; raw[i] = (t >= 0) ? *(const unsigned*)(proj + (roff0 + (unsigned)(i * PC))) : 0u; }
#pragma unroll
    for (int j = 0; j < 8; ++j) bcv[j] = *(const u32x4*)(bcb + (boff0 + (unsigned)(j * 16 * 1024)));
#pragma unroll
    for (int gq = 0; gq < 4; ++gq) zr[gq] = *(const u32x2*)(proj + (zoff0 + (unsigned)(8 * gq)));
    if (wid == 0) { dtc0 = dtbuf[(size_t)(b * 2048 + 2 * lane) * 32 + head]; dtc1 = dtbuf[(size_t)(b * 2048 + 2 * lane + 1) * 32 + head]; }
    for (int c = 0; c < 16; ++c) {
        const int R0 = b * 2048 + c * 128;
        if (wid == 0) {
            const float a0 = dtc0 * Ah, a1 = dtc1 * Ah; float s = a0 + a1;
#define SCAN_DPP(ctrl, rmask) s += __builtin_bit_cast(float, __builtin_amdgcn_update_dpp(0, __builtin_bit_cast(int, s), (ctrl), (rmask), 0xf, false))
            SCAN_DPP(0x111, 0xf); SCAN_DPP(0x112, 0xf); SCAN_DPP(0x114, 0xf); SCAN_DPP(0x118, 0xf); SCAN_DPP(0x142, 0xa); SCAN_DPP(0x143, 0xc);
#undef SCAN_DPP
            const float tot = __shfl(s, 63); const float s0 = s - a1;
            acs[2 * lane] = s0; acs[2 * lane + 1] = s; wk[2 * lane] = dtc0 * __expf(tot - s0); wk[2 * lane + 1] = dtc1 * __expf(tot - s);
            dtv[2 * lane] = dtc0; dtv[2 * lane + 1] = dtc1; eacs[2 * lane] = __expf(s0); eacs[2 * lane + 1] = __expf(s);
            if (c < 15) { dtc0 = dtbuf[(size_t)(R0 + 128 + 2 * lane) * 32 + head]; dtc1 = dtbuf[(size_t)(R0 + 128 + 2 * lane + 1) * 32 + head]; }
        }
        {
            float w0[4], w1[4];
#pragma unroll
            for (int k = 0; k < 4; ++k) { const f32x2 t = *(const f32x2*)(cw + k * 64 + 2 * xpair); w0[k] = t[0]; w1[k] = t[1]; }
            const f32x2 bt = *(const f32x2*)(cw + 4 * 64 + 2 * xpair); const float b0 = bt[0], b1 = bt[1];
#pragma unroll
            for (int i = 0; i < 8; ++i) {
                float o0 = b0, o1 = b1;
#pragma unroll
                for (int k = 0; k < 4; ++k) { o0 += w0[k] * __uint_as_float(raw[i + k] << 16); o1 += w1[k] * __uint_as_float(raw[i + k] & 0xffff0000u); }
                o0 = silu_f(o0); o1 = silu_f(o1);
                const int k = xseg * 8 + i;
                *(unsigned*)(xs + k * 72 + 2 * xpair) = pack_bf2(o0, o1);
            }
#pragma unroll
            for (int j = 0; j < 8; ++j) { const int id = tid + 512 * j, row = id >> 5, part = id & 31;
                if (part < 16) *(u32x4*)(Bs + row * 136 + part * 8) = bcv[j]; else *(u32x4*)(Cs + row * 136 + (part - 16) * 8) = bcv[j]; }
        }
        lds_barrier();
        f32x16 yoff;
        for (int i = 0; i < 16; ++i) yoff[i] = 0.f;
        if (c > 0) {
#pragma unroll
            for (int kk = 0; kk < 8; ++kk) { const bf16x8 a = *(const bf16x8*)(Cs + (qt * 32 + r) * 136 + kk * 16 + 8 * hh); const bf16x8 bb = *(const bf16x8*)(hb + (t2 * 32 + r) * 136 + kk * 16 + 8 * hh);
                yoff = MFMA32(bb, a, yoff); } }
        for (int job = 0; job < (two ? 2 : 1); ++job) {
            const int gq = job ? gq1 : gq0, gk = job ? gk1 : gk0;
            f32x16 ga; for (int i = 0; i < 16; ++i) ga[i] = 0.f;
#pragma unroll
            for (int kk = 0; kk < 8; ++kk) { const bf16x8 a = *(const bf16x8*)(Cs + (gq * 32 + r) * 136 + kk * 16 + 8 * hh); const bf16x8 bb = *(const bf16x8*)(Bs + (gk * 32 + r) * 136 + kk * 16 + 8 * hh);
                ga = MFMA32(bb, a, ga); }
            const int q = gq * 32 + r; const float aq = acs[q];
#pragma unroll
            for (int g4 = 0; g4 < 4; ++g4) { const int k4 = gk * 32 + 8 * g4 + 4 * hh; const f32x4 ak = *(const f32x4*)(acs + k4), dk = *(const f32x4*)(dtv + k4);
                float v[4];
#pragma unroll
                for (int j = 0; j < 4; ++j) v[j] = (k4 + j <= q) ? ga[4 * g4 + j] * __expf(aq - ak[j]) * dk[j] : 0.f;
                u32x2 o; o.x = pack_bf2(v[0], v[1]); o.y = pack_bf2(v[2], v[3]); *(u32x2*)(Ms + q * 136 + k4) = o; }
        }
        lds_barrier();
        {
            f32x16 yd; for (int i = 0; i < 16; ++i) yd[i] = 0.f;
#pragma unroll
            for (int kk = 0; kk < 8; ++kk) if (kk < 2 * (qt + 1)) { const bf16x8 a = *(const bf16x8*)(Ms + (qt * 32 + r) * 136 + kk * 16 + 8 * hh); const bf16x8 bb = tr_frag(xs, 72, kk * 16, t2 * 32, lane);
                yd = MFMA32(bb, a, yd); }
            const int q = qt * 32 + r; const float eq = eacs[q]; float sq = 0.f;
            unsigned zo = zoff0 + (unsigned)(c * 128 * PC); asm volatile("" : "+v"(zo));
#pragma unroll
            for (int gq = 0; gq < 4; ++gq) { const int p4 = t2 * 32 + 8 * gq + 4 * hh;
                const u32x2 xv = *(const u32x2*)(xs + q * 72 + p4); const u32x2 z = zr[gq];
                const float y0 = eq * yoff[4 * gq] + yd[4 * gq] + Dh * __uint_as_float(xv.x << 16), y1 = eq * yoff[4 * gq + 1] + yd[4 * gq + 1] + Dh * __uint_as_float(xv.x & 0xffff0000u);
                const float y2 = eq * yoff[4 * gq + 2] + yd[4 * gq + 2] + Dh * __uint_as_float(xv.y << 16), y3 = eq * yoff[4 * gq + 3] + yd[4 * gq + 3] + Dh * __uint_as_float(xv.y & 0xffff0000u);
                u32x2 o; o.x = pack_bf2(y0 * __uint_as_float(z.x << 16), y1 * __uint_as_float(z.x & 0xffff0000u)); o.y = pack_bf2(y2 * __uint_as_float(z.y << 16), y3 * __uint_as_float(z.y & 0xffff0000u));
                { const float e0 = __uint_as_float(o.x << 16), e1 = __uint_as_float(o.x & 0xffff0000u), e2 = __uint_as_float(o.y << 16), e3 = __uint_as_float(o.y & 0xffff0000u); sq += e0 * e0 + e1 * e1 + e2 * e2 + e3 * e3; }
                if (!SSD_DRY) *(u32x2*)(proj + (zo + (unsigned)(8 * gq))) = o; }
            sq += xchg32(sq, hh != 0);
            if (hh == 0 && !SSD_DRY) ((float*)(p.ws + WS_SQP2))[(size_t)(R0 + q) * 64 + head * 2 + t2] = sq;
            if (c < 15) { zo += (unsigned)(128 * PC);
#pragma unroll
                for (int gq = 0; gq < 4; ++gq) zr[gq] = *(const u32x2*)(proj + (zo + (unsigned)(8 * gq))); }
        }
        if (c < 15) {
            unsigned ro = roff0 + (unsigned)((c + 1) * 128 * PC); asm volatile("" : "+v"(ro));
#pragma unroll
            for (int i = 0; i < 11; ++i) raw[i] = *(const unsigned*)(proj + (ro + (unsigned)(i * PC)));
            unsigned bo = boff0 + (unsigned)((c + 1) * 128 * 1024); asm volatile("" : "+v"(bo));
#pragma unroll
            for (int j = 0; j < 8; ++j) bcv[j] = *(const u32x4*)(bcb + (bo + (unsigned)(j * 16 * 1024)));
        }
        {
            const float cd = eacs[127];
#pragma unroll
            for (int i = 0; i < 16; ++i) hacc[i] *= cd;
#pragma unroll
            for (int kk = 0; kk < 8; ++kk) { const u32x4 xa = __builtin_bit_cast(u32x4, tr_frag(xs, 72, kk * 16, pt * 32, lane)); const bf16x8 bb = tr_frag(Bs, 136, kk * 16, ntl * 32, lane);
                const f32x4 wa = *(const f32x4*)(wk + kk * 16 + 8 * hh), wb = *(const f32x4*)(wk + kk * 16 + 8 * hh + 4);
                u32x4 xsc; xsc.x = pack_bf2(__uint_as_float(xa.x << 16) * wa[0], __uint_as_float(xa.x & 0xffff0000u) * wa[1]); xsc.y = pack_bf2(__uint_as_float(xa.y << 16) * wa[2], __uint_as_float(xa.y & 0xffff0000u) * wa[3]);
                xsc.z = pack_bf2(__uint_as_float(xa.z << 16) * wb[0], __uint_as_float(xa.z & 0xffff0000u) * wb[1]); xsc.w = pack_bf2(__uint_as_float(xa.w << 16) * wb[2], __uint_as_float(xa.w & 0xffff0000u) * wb[3]);
                hacc = MFMA32(bb, __builtin_bit_cast(bf16x8, xsc), hacc); }
#pragma unroll
            for (int g4 = 0; g4 < 4; ++g4) { u32x2 o; o.x = pack_bf2(hacc[4 * g4], hacc[4 * g4 + 1]); o.y = pack_bf2(hacc[4 * g4 + 2], hacc[4 * g4 + 3]);
                *(u32x2*)(hb + (pt * 32 + r) * 136 + ntl * 32 + 8 * g4 + 4 * hh) = o; }
        }
        lds_barrier();
    }
    float* so = p.out + O_SSMP + (size_t)(b * 32 + head) * 8192;
#pragma unroll
    for (int g4 = 0; g4 < 4; ++g4) if (!SSD_DRY) *(f32x4*)(so + (pt * 32 + r) * 128 + ntl * 32 + 8 * g4 + 4 * hh) = (f32x4){hacc[4 * g4], hacc[4 * g4 + 1], hacc[4 * g4 + 2], hacc[4 * g4 + 3]};
}

DI void bc_conv_pass(const Params& p, const int wid_s) {
    const int tid = tid_opaque(wid_s), G = gridDim.x, bid = blockIdx.x;
    { const int wid = tid >> 6, lane = tid & 63, r = lane & 31, hh = lane >> 5;
      for (int T = bid + G * wid; T < NTOK / 32; T += G * 8) {
          const bf16_t* ap = (const bf16_t*)(p.ws + WS_H) + (size_t)(T * 32 + r) * 1024 + 8 * hh;
          const bf16_t* bp = (const bf16_t*)(p.ws + WS_SSQP) + (size_t)r * 1024 + 8 * hh;
          f32x16 acc; for (int i = 0; i < 16; ++i) acc[i] = 0.f;
#pragma unroll 8
          for (int kk = 0; kk < 64; ++kk) acc = MFMA32(*(const bf16x8*)(ap + kk * 16), *(const bf16x8*)(bp + kk * 16), acc);
          const float bias = p.in[14][r]; float* dtb = (float*)(p.ws + WS_DT);
#pragma unroll
          for (int i = 0; i < 16; ++i) { const float v = acc[i] + bias; dtb[(size_t)(T * 32 + crow(i, hh)) * 32 + r] = v > 20.f ? v : log1pf(__expf(v)); }
      } }
    const bf16_t* proj = (const bf16_t*)(p.ws + WS_PROJ);
    bf16_t* bcb = (bf16_t*)(p.ws + WS_PART3);
    const float* convw = p.in[12]; const float* convb = p.in[13];
    for (int task = bid * 512 + tid; task < 1024 * 512; task += G * 512) {
        const int cp = task & 511, sg = task >> 9; const int ch = 2048 + 2 * cp; const int R = sg * 16, pos = R & 2047;
        const bf16_t* src = proj + (size_t)R * PC + C_XBC + ch;
        unsigned raw[19];
#pragma unroll
        for (int i = 0; i < 19; ++i) raw[i] = (pos + i - 3 >= 0) ? __builtin_nontemporal_load((const unsigned*)(src + (ptrdiff_t)(i - 3) * PC)) : 0u;
        float w0[4], w1[4];
#pragma unroll
        for (int k = 0; k < 4; ++k) { w0[k] = convw[k * 3072 + ch]; w1[k] = convw[k * 3072 + ch + 1]; }
        const float b0 = convb[ch], b1 = convb[ch + 1];
#pragma unroll
        for (int i = 0; i < 16; ++i) { float o0 = b0, o1 = b1;
#pragma unroll
            for (int k = 0; k < 4; ++k) { o0 += w0[k] * __uint_as_float(raw[i + k] << 16); o1 += w1[k] * __uint_as_float(raw[i + k] & 0xffff0000u); }
            *(unsigned*)(bcb + (size_t)(R + i) * 1024 + 2 * cp) = pack_bf2(silu_f(o0), silu_f(o1)); }
    }
    for (int task = bid * 512 + tid; task < 128 * 512; task += G * 512) {
        const int cp = task & 511, bs = task >> 9; const int ch = 2048 + 2 * cp; const int R = NPROMPT + bs * 8;
        float e0[11], e1[11];
#pragma unroll
        for (int j = 0; j < 3; ++j) { const f32x2 sv = *(const f32x2*)(p.in[4] + ((size_t)bs * 3 + j) * 3072 + ch); e0[j] = sv[0]; e1[j] = sv[1]; }
#pragma unroll
        for (int k = 0; k < 8; ++k) { const unsigned v = *(const unsigned*)(proj + (size_t)(R + k) * PC + C_XBC + ch); e0[3 + k] = __uint_as_float(v << 16); e1[3 + k] = __uint_as_float(v & 0xffff0000u); }
        float w0[4], w1[4];
#pragma unroll
        for (int k = 0; k < 4; ++k) { w0[k] = convw[k * 3072 + ch]; w1[k] = convw[k * 3072 + ch + 1]; }
        const float b0 = convb[ch], b1 = convb[ch + 1];
#pragma unroll
        for (int i = 0; i < 8; ++i) { float o0 = b0, o1 = b1;
#pragma unroll
            for (int k = 0; k < 4; ++k) { o0 += w0[k] * e0[i + k]; o1 += w1[k] * e1[i + k]; }
            *(unsigned*)(bcb + (size_t)(R + i) * 1024 + 2 * cp) = pack_bf2(silu_f(o0), silu_f(o1)); }
    }
}

DI void ssd_sample_item(const Params& p, unsigned char* lds, int item, const int wid_s, const bool dry = false) {
    const int tid = tid_opaque(wid_s), wid = tid >> 6, lane = tid & 63;
    const int pair = item * 8 + wid, b = pair >> 5, head = pair & 31, g = head >> 3;
    bf16_t* proj = (bf16_t*)(p.ws + WS_PROJ);
    const float* dtbuf = (const float*)(p.ws + WS_DT);
    const float Ah = -__expf(p.in[15][head]);
    const float Dh = p.in[16][head];
    const float* convw = p.in[12]; const float* convb = p.in[13];
    const int R0 = NPROMPT + b * 8;
    float* L = (float*)(lds + wid * 12800);
    float* xw = L;
    float* Bv = xw + 512;
    float* Cv = Bv + 1024;
    float* Mm = Cv + 1024;
    float* Yo = Mm + 64;
    float* sc = Yo + 512;
    float dtk[8], acs[8], eq[8], wv[8];
    { float s = 0.f;
#pragma unroll
        for (int k = 0; k < 8; ++k) { dtk[k] = dtbuf[(size_t)(R0 + k) * 32 + head]; s += dtk[k] * Ah; acs[k] = s; }
#pragma unroll
        for (int k = 0; k < 8; ++k) { eq[k] = __expf(acs[k]); wv[k] = dtk[k] * __expf(acs[7] - acs[k]); } }
    const float cd = __expf(acs[7]);
    if (lane < 8) { sc[lane] = acs[0]; }
#pragma unroll
    for (int k = 0; k < 8; ++k) if (lane == k) { sc[k] = acs[k]; sc[8 + k] = dtk[k]; }
    float xs[8];
    const float* sconv = p.in[4] + (size_t)b * 3 * 3072;
    { const int ch = head * 64 + lane;
        float e[11];
#pragma unroll
        for (int j = 0; j < 3; ++j) e[j] = sconv[j * 3072 + ch];
#pragma unroll
        for (int k = 0; k < 8; ++k) e[3 + k] = bf2f(proj[(size_t)(R0 + k) * PC + C_XBC + ch]);
        const float w0 = convw[ch], w1 = convw[3072 + ch], w2 = convw[2 * 3072 + ch], w3 = convw[3 * 3072 + ch], bb = convb[ch];
#pragma unroll
        for (int k = 0; k < 8; ++k) { const float o = silu_f(bb + w0 * e[k] + w1 * e[k + 1] + w2 * e[k + 2] + w3 * e[k + 3]); xs[k] = o; xw[lane * 8 + k] = o * wv[k]; }
        const bf16_t* bcb = (const bf16_t*)(p.ws + WS_PART3) + (size_t)R0 * 1024 + g * 128;
#pragma unroll
        for (int k = 0; k < 8; ++k) { const unsigned vb = *(const unsigned*)(bcb + (size_t)k * 1024 + 2 * lane), vc = *(const unsigned*)(bcb + (size_t)k * 1024 + 512 + 2 * lane);
            *(f32x2*)(Bv + k * 128 + 2 * lane) = (f32x2){__uint_as_float(vb << 16), __uint_as_float(vb & 0xffff0000u)};
            *(f32x2*)(Cv + k * 128 + 2 * lane) = (f32x2){__uint_as_float(vc << 16), __uint_as_float(vc & 0xffff0000u)}; }
    }
    lds_barrier();
    { const int q = lane >> 3, k = lane & 7; float gsum = 0.f;
        if (k <= q) {
            for (int n = 0; n < 128; n += 4) { const f32x4 cv = *(const f32x4*)(Cv + q * 128 + n); const f32x4 bv = *(const f32x4*)(Bv + k * 128 + n);
                gsum += cv[0] * bv[0] + cv[1] * bv[1] + cv[2] * bv[2] + cv[3] * bv[3]; }
            gsum *= __expf(sc[q] - sc[k]) * sc[8 + k];
        }
        Mm[lane] = gsum; }
    lds_barrier();
    float yd[8];
#pragma unroll
    for (int q = 0; q < 8; ++q) { float s = 0.f;
#pragma unroll
        for (int k = 0; k < 8; ++k) s += Mm[q * 8 + k] * xs[k];
        yd[q] = s; }
    const int half = lane >> 5, nl = lane & 31;
    f32x4 Bq[8], Cq[8];
#pragma unroll
    for (int k = 0; k < 8; ++k) { Bq[k] = *(const f32x4*)(Bv + k * 128 + 4 * nl); Cq[k] = *(const f32x4*)(Cv + k * 128 + 4 * nl); }
    const float* h0 = p.in[5] + (size_t)pair * 8192;
    float* hn = p.out + O_SSMS + (size_t)pair * 8192;
    for (int i0 = 0; i0 < 32; i0 += 8) {
        f32x4 hv[8];
#pragma unroll
        for (int u = 0; u < 8; ++u) hv[u] = __builtin_nontemporal_load((const f32x4*)(h0 + (2 * (i0 + u) + half) * 128 + 4 * nl));
#pragma unroll
        for (int u = 0; u < 8; ++u) {
            const int pp = 2 * (i0 + u) + half;
            float v[8];
#pragma unroll
            for (int q = 0; q < 8; ++q) v[q] = Cq[q][0] * hv[u][0] + Cq[q][1] * hv[u][1] + Cq[q][2] * hv[u][2] + Cq[q][3] * hv[u][3];
            float v4[4], v2[2], v1;
            const bool b4 = (nl & 16) != 0, b3 = (nl & 8) != 0, b2 = (nl & 4) != 0;
#pragma unroll
            for (int j = 0; j < 4; ++j) { const float send = b4 ? v[j] : v[j + 4], keep = b4 ? v[j + 4] : v[j]; v4[j] = keep + xchg16(send, b4); }
#pragma unroll
            for (int j = 0; j < 2; ++j) { const float send = b3 ? v4[j] : v4[j + 2], keep = b3 ? v4[j + 2] : v4[j]; v2[j] = keep + xchg8(send); }
            { const float send = b2 ? v2[0] : v2[1], keep = b2 ? v2[1] : v2[0]; v1 = keep + xchg_hm(send); }
            v1 = dpp_add_x1(v1); v1 = dpp_add_x2(v1);
            if ((nl & 3) == 0) Yo[pp * 8 + (nl >> 2)] = v1;
            const f32x4 xa = *(const f32x4*)(xw + pp * 8), xb = *(const f32x4*)(xw + pp * 8 + 4);
            f32x4 hnew = hv[u] * cd;
            hnew += Bq[0] * xa[0]; hnew += Bq[1] * xa[1]; hnew += Bq[2] * xa[2]; hnew += Bq[3] * xa[3];
            hnew += Bq[4] * xb[0]; hnew += Bq[5] * xb[1]; hnew += Bq[6] * xb[2]; hnew += Bq[7] * xb[3];
            if (!dry) __builtin_nontemporal_store(hnew, (f32x4*)(hn + pp * 128 + 4 * nl));
        }
    }
    lds_barrier();
#pragma unroll
    for (int q = 0; q < 8; ++q) {
        const float y = eq[q] * Yo[lane * 8 + q] + yd[q] + Dh * xs[q];
        const size_t addr = (size_t)(R0 + q) * PC + C_SZ + head * 64 + lane;
        if (!dry) proj[addr] = f2bf(y * bf2f(proj[addr]));
    }
}

DI void attn_prompt_item(const Params& p, unsigned char* lds, int item, const int wid_s, const bool dry = false) {
    const int tid = tid_opaque(wid_s), wid = tid >> 6, lane = tid & 63, r = lane & 31, hh = lane >> 5;
    const int b = item >> 5, h = (item >> 3) & 3, qt = item & 7;
    bf16_t* proj = (bf16_t*)(p.ws + WS_PROJ);
    const int R0 = b * 2048 + qt * 256 + wid * 32;
    bf16_t* Ks = (bf16_t*)lds;
    bf16_t* VT = Ks + 256 * 72;
    const float* Kg = p.out + O_MK + (size_t)(b * 256) * 1024 + h * 256;
    const float* Vg = p.out + O_MV + (size_t)(b * 256) * 1024 + h * 256;
    f32x16 sacc[8];
#pragma unroll
    for (int kt = 0; kt < 8; ++kt) for (int i = 0; i < 16; ++i) sacc[kt][i] = 0.f;
    const bf16_t* qrow = proj + (size_t)(R0 + r) * PC + C_Q + h * 256 + 8 * hh;
    const int skey = tid >> 1, sd0 = (tid & 1) * 32;
    f32x4 stg[8];
#pragma unroll
    for (int j = 0; j < 8; ++j) stg[j] = *(const f32x4*)(Kg + (size_t)skey * 1024 + sd0 + 4 * j);
    for (int dc = 0; dc < 4; ++dc) {
        bf16x8 bq[4];
#pragma unroll
        for (int kk = 0; kk < 4; ++kk) bq[kk] = *(const bf16x8*)(qrow + dc * 64 + kk * 16);
#pragma unroll
        for (int j = 0; j < 4; ++j) { const f32x4 a = stg[2 * j], c4 = stg[2 * j + 1];
            u32x4 w; w.x = pack_bf2(a[0], a[1]); w.y = pack_bf2(a[2], a[3]); w.z = pack_bf2(c4[0], c4[1]); w.w = pack_bf2(c4[2], c4[3]);
            *(u32x4*)(Ks + skey * 72 + sd0 + 8 * j) = w; }
        lds_barrier();
        if (dc < 3) {
#pragma unroll
            for (int j = 0; j < 8; ++j) stg[j] = *(const f32x4*)(Kg + (size_t)skey * 1024 + (dc + 1) * 64 + sd0 + 4 * j); }
#pragma unroll
        for (int kt = 0; kt < 8; ++kt)
#pragma unroll
            for (int kk = 0; kk < 4; ++kk) { const bf16x8 a = *(const bf16x8*)(Ks + (kt * 32 + r) * 72 + kk * 16 + 8 * hh); sacc[kt] = MFMA32(a, bq[kk], sacc[kt]); }
        lds_barrier();
    }
    const int vdg = tid & 15, vkb = tid >> 4;
#pragma unroll
    for (int it = 0; it < 8; ++it) stg[it] = *(const f32x4*)(Vg + (size_t)(vkb + 32 * it) * 1024 + 4 * vdg);
    float m = -3.0e38f;
#pragma unroll
    for (int kt = 0; kt < 8; ++kt)
#pragma unroll
        for (int i = 0; i < 16; ++i) m = fmaxf(m, sacc[kt][i]);
    m = fmaxf(m, __shfl_xor(m, 32));
    float l = 0.f;
#pragma unroll
    for (int kt = 0; kt < 8; ++kt)
#pragma unroll
        for (int i = 0; i < 16; ++i) { const float e = __expf(sacc[kt][i] - m); sacc[kt][i] = e; l += e; }
    l += __shfl_xor(l, 32);
    const float inv = 1.0f / l;
    bf16x8 pk[8][2];
#pragma unroll
    for (int kt = 0; kt < 8; ++kt)
#pragma unroll
        for (int s = 0; s < 2; ++s) { u32x4 w; w.x = pack_bf2(sacc[kt][8 * s], sacc[kt][8 * s + 1]); w.y = pack_bf2(sacc[kt][8 * s + 2], sacc[kt][8 * s + 3]);
            w.z = pack_bf2(sacc[kt][8 * s + 4], sacc[kt][8 * s + 5]); w.w = pack_bf2(sacc[kt][8 * s + 6], sacc[kt][8 * s + 7]); pk[kt][s] = __builtin_bit_cast(bf16x8, w); }
    for (int dc = 0; dc < 4; ++dc) {
#pragma unroll
        for (int it = 0; it < 8; ++it) { const int key = vkb + 32 * it;
#pragma unroll
            for (int j = 0; j < 4; ++j) VT[(4 * vdg + j) * 260 + key] = f2bf(stg[it][j]); }
        lds_barrier();
        if (dc < 3) {
#pragma unroll
            for (int it = 0; it < 8; ++it) stg[it] = *(const f32x4*)(Vg + (size_t)(vkb + 32 * it) * 1024 + (dc + 1) * 64 + 4 * vdg); }
        u32x2 zv[8];
#pragma unroll
        for (int d2 = 0; d2 < 2; ++d2)
#pragma unroll
            for (int gq = 0; gq < 4; ++gq) zv[d2 * 4 + gq] = *(const u32x2*)(proj + (size_t)(R0 + r) * PC + h * 256 + dc * 64 + d2 * 32 + 8 * gq + 4 * hh + C_AZ);
        f32x16 oacc[2];
#pragma unroll
        for (int d2 = 0; d2 < 2; ++d2) for (int i = 0; i < 16; ++i) oacc[d2][i] = 0.f;
#pragma unroll
        for (int kt = 0; kt < 8; ++kt)
#pragma unroll
            for (int s2 = 0; s2 < 2; ++s2)
#pragma unroll
                for (int d2 = 0; d2 < 2; ++d2) { const bf16_t* vr = VT + (d2 * 32 + r) * 260 + kt * 32 + 16 * s2 + 4 * hh;
                    const u32x2 lo = *(const u32x2*)vr, hi = *(const u32x2*)(vr + 8); u32x4 w; w.x = lo.x; w.y = lo.y; w.z = hi.x; w.w = hi.y;
                    oacc[d2] = MFMA32(__builtin_bit_cast(bf16x8, w), pk[kt][s2], oacc[d2]); }
#pragma unroll
        for (int d2 = 0; d2 < 2; ++d2)
#pragma unroll
            for (int gq = 0; gq < 4; ++gq) { const int d = dc * 64 + d2 * 32 + 8 * gq + 4 * hh;
                const size_t rowb = (size_t)(R0 + r) * PC + h * 256 + d;
                const u32x2 z = zv[d2 * 4 + gq];
                u32x2 o; o.x = pack_bf2(oacc[d2][4 * gq] * inv * __uint_as_float(z.x << 16), oacc[d2][4 * gq + 1] * inv * __uint_as_float(z.x & 0xffff0000u));
                o.y = pack_bf2(oacc[d2][4 * gq + 2] * inv * __uint_as_float(z.y << 16), oacc[d2][4 * gq + 3] * inv * __uint_as_float(z.y & 0xffff0000u));
                if (!dry) *(u32x2*)(proj + rowb + C_Q) = o; }
        lds_barrier();
    }
}

DI void attn_sample_item(const Params& p, unsigned char* lds, int item, const int wid_s, const bool dry = false) {
    const int tid = tid_opaque(wid_s), wid = tid >> 6, lane = tid & 63;
    const int b = item >> 2, h = item & 3;
    bf16_t* proj = (bf16_t*)(p.ws + WS_PROJ);
    const int R0 = NPROMPT + b * 8;
    float* S = (float*)lds;
    float* P = S + 2048;
    float* red = P + 2048;
    const float* Kg = p.in[6] + ((size_t)(b * 256) * 4 + h) * 256;
    const float* Vg = p.in[7] + ((size_t)(b * 256) * 4 + h) * 256;
    f32x4 q4[8];
#pragma unroll
    for (int q = 0; q < 8; ++q) { const u32x2 w = *(const u32x2*)(proj + (size_t)(R0 + q) * PC + C_Q + h * 256 + 4 * lane);
        q4[q] = (f32x4){__uint_as_float(w.x << 16), __uint_as_float(w.x & 0xffff0000u), __uint_as_float(w.y << 16), __uint_as_float(w.y & 0xffff0000u)}; }
    const bool b5 = (lane & 32) != 0, b4 = (lane & 16) != 0, b3 = (lane & 8) != 0;
    for (int k0 = 0; k0 < 32; k0 += 16) {
        f32x4 kv[16];
#pragma unroll
        for (int u = 0; u < 16; ++u) kv[u] = __builtin_nontemporal_load((const f32x4*)(Kg + (size_t)(wid * 32 + k0 + u) * 1024 + 4 * lane));
#pragma unroll
        for (int u = 0; u < 16; ++u) {
            float v[8];
#pragma unroll
            for (int q = 0; q < 8; ++q) v[q] = q4[q][0] * kv[u][0] + q4[q][1] * kv[u][1] + q4[q][2] * kv[u][2] + q4[q][3] * kv[u][3];
            float v4[4], v2[2], v1;
#pragma unroll
            for (int j = 0; j < 4; ++j) { const float send = b5 ? v[j] : v[j + 4], keep = b5 ? v[j + 4] : v[j]; v4[j] = keep + xchg32(send, b5); }
#pragma unroll
            for (int j = 0; j < 2; ++j) { const float send = b4 ? v4[j] : v4[j + 2], keep = b4 ? v4[j + 2] : v4[j]; v2[j] = keep + xchg16(send, b4); }
            { const float send = b3 ? v2[0] : v2[1], keep = b3 ? v2[1] : v2[0]; v1 = keep + xchg8(send); }
            v1 = dpp_add_x1(v1); v1 = dpp_add_x2(v1); v1 = dpp_add_hm(v1);
            if ((lane & 7) == 0) S[(lane >> 3) * 256 + wid * 32 + k0 + u] = v1;
        }
    }
    lds_barrier();
    { const f32x4 s4 = *(const f32x4*)(S + wid * 256 + 4 * lane);
        float m = fmaxf(fmaxf(s4[0], s4[1]), fmaxf(s4[2], s4[3]));
#pragma unroll
        for (int o = 32; o > 0; o >>= 1) m = fmaxf(m, __shfl_xor(m, o));
        f32x4 e; float l = 0.f;
#pragma unroll
        for (int j = 0; j < 4; ++j) { e[j] = __expf(s4[j] - m); l += e[j]; }
#pragma unroll
        for (int o = 32; o > 0; o >>= 1) l += __shfl_xor(l, o);
        const float inv = 1.0f / l;
#pragma unroll
        for (int j = 0; j < 4; ++j) P[(4 * lane + j) * 8 + wid] = e[j] * inv; }
    lds_barrier();
    f32x4 oa[8];
#pragma unroll
    for (int q = 0; q < 8; ++q) oa[q] = (f32x4){0.f, 0.f, 0.f, 0.f};
    for (int k0 = 0; k0 < 32; k0 += 16) {
        f32x4 vv[16];
#pragma unroll
        for (int u = 0; u < 16; ++u) vv[u] = __builtin_nontemporal_load((const f32x4*)(Vg + (size_t)(wid * 32 + k0 + u) * 1024 + 4 * lane));
#pragma unroll
        for (int u = 0; u < 16; ++u) { const int key = wid * 32 + k0 + u; const f32x4 pa = *(const f32x4*)(P + key * 8), pb = *(const f32x4*)(P + key * 8 + 4);
            oa[0] += vv[u] * pa[0]; oa[1] += vv[u] * pa[1]; oa[2] += vv[u] * pa[2]; oa[3] += vv[u] * pa[3];
            oa[4] += vv[u] * pb[0]; oa[5] += vv[u] * pb[1]; oa[6] += vv[u] * pb[2]; oa[7] += vv[u] * pb[3]; }
    }
#pragma unroll
    for (int q = 0; q < 8; ++q) *(f32x4*)(red + (wid * 8 + q) * 256 + 4 * lane) = oa[q];
    lds_barrier();
    { const int q = tid >> 6, d = 4 * (tid & 63); f32x4 s = {0.f, 0.f, 0.f, 0.f};
#pragma unroll
        for (int w = 0; w < 8; ++w) s += *(const f32x4*)(red + (w * 8 + q) * 256 + d);
        const size_t rowb = (size_t)(R0 + q) * PC + h * 256 + d;
        const u32x2 z = *(const u32x2*)(proj + rowb + C_AZ);
        u32x2 o; o.x = pack_bf2(s[0] * __uint_as_float(z.x << 16), s[1] * __uint_as_float(z.x & 0xffff0000u));
        o.y = pack_bf2(s[2] * __uint_as_float(z.y << 16), s[3] * __uint_as_float(z.y & 0xffff0000u));
        if (!dry) *(u32x2*)(proj + rowb + C_Q) = o; }
}

template <int W>
DI void pool_fill_prompt(const bf16_t* proj, bf16_t* As, int R0, int c0, int tid) {
    const int cp = tid & 127, seg = tid >> 7;
    const int col = c0 + 2 * cp, rbase = R0 + seg * 32, pos0 = rbase & 2047;
    unsigned raw[32 + W - 1];
#pragma unroll
    for (int i = 0; i < 32 + W - 1; ++i) { const int o = i - (W - 1); raw[i] = (pos0 + o >= 0) ? *(const unsigned*)(proj + (size_t)(rbase + o) * PC + col) : 0u; }
    float s0 = 0.f, s1 = 0.f;
#pragma unroll
    for (int i = 0; i < W - 1; ++i) { s0 += __uint_as_float(raw[i] << 16); s1 += __uint_as_float(raw[i] & 0xffff0000u); }
#pragma unroll
    for (int i = 0; i < 32; ++i) {
        const unsigned cur = raw[i + W - 1]; const float u0 = __uint_as_float(cur << 16), u1 = __uint_as_float(cur & 0xffff0000u);
        s0 += u0; s1 += u1;
        const int pos = pos0 + i; const float inv = 1.0f / (float)((pos + 1) < W ? (pos + 1) : W);
        *(unsigned*)(As + (seg * 32 + i) * 264 + 2 * cp) = pack_bf2(s0 * inv - u0, s1 * inv - u1);
        s0 -= __uint_as_float(raw[i] << 16); s1 -= __uint_as_float(raw[i] & 0xffff0000u);
    }
}
template <int W>
DI void pool_fill_sample(const Params& p, const bf16_t* proj, bf16_t* As, int R0, int c0, int tid) {
    for (int task = tid; task < 2048; task += 512) {
        const int cp = task & 127, bl = task >> 7; const int col = c0 + 2 * cp, row0 = R0 + bl * 8, bs = (row0 - NPROMPT) >> 3;
        float e0[W + 7], e1[W + 7];
#pragma unroll
        for (int i = 0; i < W - 1; ++i) { const f32x2 sv = *(const f32x2*)(p.in[3] + ((size_t)bs * 15 + 15 - (W - 1) + i) * 1024 + col); e0[i] = sv[0]; e1[i] = sv[1]; }
#pragma unroll
        for (int k = 0; k < 8; ++k) { const unsigned v = *(const unsigned*)(proj + (size_t)(row0 + k) * PC + col); e0[W - 1 + k] = __uint_as_float(v << 16); e1[W - 1 + k] = __uint_as_float(v & 0xffff0000u); }
#pragma unroll
        for (int tl = 0; tl < 8; ++tl) { float s0 = 0.f, s1 = 0.f;
#pragma unroll
            for (int j = 0; j < W; ++j) { s0 += e0[W - 1 + tl - j]; s1 += e1[W - 1 + tl - j]; }
            *(unsigned*)(As + (bl * 8 + tl) * 264 + 2 * cp) = pack_bf2(s0 * (1.0f / W) - e0[W - 1 + tl], s1 * (1.0f / W) - e1[W - 1 + tl]); }
    }
}
DI void pool_item(const Params& p, unsigned char* lds, int item, const int wid_s, const bool dry = false) {
    const int tid = tid_opaque(wid_s), wid = tid >> 6, lane = tid & 63, r = lane & 31, hh = lane >> 5;
    const int rt = item >> 2, g = item & 3;
    bf16_t* proj = (bf16_t*)(p.ws + WS_PROJ);
    bf16_t* As = (bf16_t*)lds;
    const int R0 = rt * 128, c0 = g * 256;
    const bf16_t* wpg = (const bf16_t*)(p.ws + WS_WPG) + (size_t)g * 65536;
    bf16x8 bfrag[16];
#pragma unroll
    for (int kk = 0; kk < 16; ++kk) bfrag[kk] = *(const bf16x8*)(wpg + (size_t)(wid * 32 + r) * 256 + kk * 16 + 8 * hh);
    if (R0 < NPROMPT) {
        if (g == 0) pool_fill_prompt<2>(proj, As, R0, c0, tid); else if (g == 1) pool_fill_prompt<4>(proj, As, R0, c0, tid);
        else if (g == 2) pool_fill_prompt<8>(proj, As, R0, c0, tid); else pool_fill_prompt<16>(proj, As, R0, c0, tid);
    } else {
        if (g == 0) pool_fill_sample<2>(p, proj, As, R0, c0, tid); else if (g == 1) pool_fill_sample<4>(p, proj, As, R0, c0, tid);
        else if (g == 2) pool_fill_sample<8>(p, proj, As, R0, c0, tid); else pool_fill_sample<16>(p, proj, As, R0, c0, tid);
    }
    lds_barrier();
    f32x16 acc[4];
#pragma unroll
    for (int t = 0; t < 4; ++t) for (int i = 0; i < 16; ++i) acc[t][i] = 0.f;
#pragma unroll
    for (int t = 0; t < 4; ++t)
#pragma unroll
        for (int kk = 0; kk < 16; ++kk) { const bf16x8 bd = *(const bf16x8*)(As + (t * 32 + r) * 264 + kk * 16 + 8 * hh); acc[t] = MFMA32(bfrag[kk], bd, acc[t]); }
#pragma unroll
    for (int t = 0; t < 4; ++t) {
        u32x2 zv[4];
#pragma unroll
        for (int gq = 0; gq < 4; ++gq) zv[gq] = *(const u32x2*)(proj + (size_t)(R0 + t * 32 + r) * PC + C_PZ + c0 + wid * 32 + 8 * gq + 4 * hh);
#pragma unroll
        for (int gq = 0; gq < 4; ++gq) { const int ch = c0 + wid * 32 + 8 * gq + 4 * hh; const f32x4 scl = *(const f32x4*)(p.in[11] + ch);
            u32x2 o; o.x = pack_bf2(acc[t][4 * gq] * scl[0] * __uint_as_float(zv[gq].x << 16), acc[t][4 * gq + 1] * scl[1] * __uint_as_float(zv[gq].x & 0xffff0000u));
            o.y = pack_bf2(acc[t][4 * gq + 2] * scl[2] * __uint_as_float(zv[gq].y << 16), acc[t][4 * gq + 3] * scl[3] * __uint_as_float(zv[gq].y & 0xffff0000u));
            if (!dry) *(u32x2*)(proj + (size_t)(R0 + t * 32 + r) * PC + C_PZ + ch) = o; }
    }
}

DI void copy_pass(const Params& p, const int wid_s) {
    const int tid = tid_opaque(wid_s), wid = tid >> 6, lane = tid & 63, G = gridDim.x, bid = blockIdx.x;
    const bf16_t* proj = (const bf16_t*)(p.ws + WS_PROJ);
    for (int chunk = bid * 8 + wid; chunk < 3264; chunk += G * 8) {
        float* dst; const bf16_t* sb = nullptr; const float* sf = nullptr;
        if (chunk < 120) { const int b = chunk / 15, j = chunk % 15; dst = p.out + O_POOLP + (size_t)chunk * 1024; sb = proj + (size_t)(b * 2048 + 2033 + j) * PC + C_PU; }
        else if (chunk < 192) { const int q = chunk - 120, row = q / 3, part = q % 3, b = row / 3, j = row % 3; dst = p.out + O_CONVP + (size_t)row * 3072 + part * 1024; sb = proj + (size_t)(b * 2048 + 2045 + j) * PC + C_XBC + part * 1024; }
        else if (chunk < 2112) { const int q = chunk - 192, b = q / 15, j = q % 15; dst = p.out + O_POOLS + (size_t)q * 1024;
            if (j < 7) sf = p.in[3] + ((size_t)b * 15 + 8 + j) * 1024; else sb = proj + (size_t)(NPROMPT + b * 8 + j - 7) * PC + C_PU; }
        else { const int q = chunk - 2112, row = q / 3, part = q % 3, b = row / 3, j = row % 3; dst = p.out + O_CONVS + (size_t)row * 3072 + part * 1024; sb = proj + (size_t)(NPROMPT + b * 8 + 5 + j) * PC + C_XBC + part * 1024; }
#pragma unroll
        for (int hf = 0; hf < 2; ++hf) { const int e = hf * 512 + lane * 8;
            f32x4 lo, hi;
            if (sf) { lo = *(const f32x4*)(sf + e); hi = *(const f32x4*)(sf + e + 4); }
            else { const u32x4 v = *(const u32x4*)(sb + e);
                lo = (f32x4){__uint_as_float(v.x << 16), __uint_as_float(v.x & 0xffff0000u), __uint_as_float(v.y << 16), __uint_as_float(v.y & 0xffff0000u)};
                hi = (f32x4){__uint_as_float(v.z << 16), __uint_as_float(v.z & 0xffff0000u), __uint_as_float(v.w << 16), __uint_as_float(v.w & 0xffff0000u)}; }
            *(f32x4*)(dst + e) = lo; *(f32x4*)(dst + e + 4) = hi; }
    }
}

DI void copy_item(const Params& p, int item, const int wid_s) {
    const bf16_t* proj = (const bf16_t*)(p.ws + WS_PROJ);
    const int tid = tid_opaque(wid_s);
    const int n0 = 8 * 15 * 1024, n1 = 8 * 3 * 3072, n2 = 128 * 15 * 1024, n3 = 128 * 3 * 3072, total = n0 + n1 + n2 + n3;
    for (int i = item * 512 + tid; i < total; i += 64 * 512) {
        int e = i;
        if (e < n0) { const int b = e / 15360, j = (e / 1024) % 15, c = e & 1023; p.out[O_POOLP + e] = bf2f(proj[(size_t)(b * 2048 + 2033 + j) * PC + C_PU + c]); continue; }
        e -= n0;
        if (e < n1) { const int b = e / 9216, j = (e / 3072) % 3, c = e % 3072; p.out[O_CONVP + e] = bf2f(proj[(size_t)(b * 2048 + 2045 + j) * PC + C_XBC + c]); continue; }
        e -= n1;
        if (e < n2) { const int b = e / 15360, j = (e / 1024) % 15, c = e & 1023;
            p.out[O_POOLS + e] = j < 7 ? p.in[3][((size_t)b * 15 + 8 + j) * 1024 + c] : bf2f(proj[(size_t)(NPROMPT + b * 8 + j - 7) * PC + C_PU + c]); continue; }
        e -= n2;
        { const int b = e / 9216, j = (e / 3072) % 3, c = e % 3072; p.out[O_CONVS + e] = bf2f(proj[(size_t)(NPROMPT + b * 8 + 5 + j) * PC + C_XBC + c]); }
    }
}

constexpr int N_T0 = 256, N_T1 = 256, N_T2 = 544, N_T3 = 512, N_T4 = 512, N_T5 = 64;
constexpr int P2_TOTAL = N_T0 + N_T1 + N_T2 + N_T3 + N_T4 + N_T5;

__global__ void __launch_bounds__(512, 2) mega(Params p) {
    extern __shared__ __attribute__((aligned(16))) unsigned char shm[];
    cg::grid_group grid = cg::this_grid();
    const int wid_s = __builtin_amdgcn_readfirstlane((int)threadIdx.x >> 6);
    const int G = gridDim.x, bid = blockIdx.x;
    unsigned char* ws = p.ws;
    LAS unsigned char* lds3 = (LAS unsigned char*)shm;
    { volatile LAS unsigned* st = (volatile LAS unsigned*)(lds3 + QSLOT_OFF + 16); if (tid_opaque(wid_s) == 0) { st[0] = 0u; st[1] = 0u; } __syncthreads(); }
    const XcdBarrier xb = xcd_barrier_post((unsigned*)(ws + WS_BAR), (volatile LAS unsigned*)(lds3 + QSLOT_OFF + 16), wid_s);

    phase0(p, shm, wid_s);
#if PROBE == 1
    grid.sync(); phase0(p, shm, wid_s);
#endif
    if (p.out == nullptr) grid.sync();
    xcd_barrier(xb, wid_s);

    { SchedP1 S; S.h = (const char*)(ws + WS_H); S.win = (const char*)(ws + WS_WIN); S.mh = (const char*)(ws + WS_MH); S.wkv = (const char*)(ws + WS_WKV); S.G = G; S.c = bid;
      EpiP1 E; E.proj = (bf16_t*)(ws + WS_PROJ); E.out = p.out;
      for (int rep = 0; rep < (PROBE == 2 ? 1 + ONE_RT : 1); ++rep) { if (rep) grid.sync(); gemm_phase(lds3, 1024, 1024, 1024, S, E, wid_s); } }
    xcd_barrier(xb, wid_s);

    bc_conv_pass(p, wid_s);
    copy_pass(p, wid_s);
    xcd_barrier(xb, wid_s);

    { int* qslot = (int*)(shm + QSLOT_OFF);
      unsigned* ctr = (unsigned*)(ws + WS_CTR);
#define P2_LOOP(T, N, CALL) for (;;) { __syncthreads(); if (tid_opaque(wid_s) == 0) *qslot = (int)atomicAdd(ctr + (T), 1u); __syncthreads(); const int item = *qslot; if (item >= (N)) break; CALL; }
      for (int pass = 0; pass < (PROBE == 3 ? 1 + ONE_RT : 1); ++pass) { __syncthreads(); if (tid_opaque(wid_s) == 0) qslot[1] = pass ? PROBE_LVL : 0; P2_LOOP(0 + 8 * pass, N_T0, ssd_prompt_item(p, shm, item, wid_s)) }
      for (int pass = 0; pass < ((PROBE == 4 || PROBE == 7) ? 1 + ONE_RT : 1); ++pass) P2_LOOP(1 + 8 * pass, N_T1, attn_prompt_item(p, shm, item, wid_s, pass > 0))
      for (int pass = 0; pass < ((PROBE == 4 || PROBE == 8) ? 1 + ONE_RT : 1); ++pass) P2_LOOP(2 + 8 * pass, N_T2, pool_item(p, shm, item, wid_s, pass > 0))
      for (int pass = 0; pass < ((PROBE == 5 || PROBE == 9) ? 1 + ONE_RT : 1); ++pass) P2_LOOP(3 + 8 * pass, N_T3, ssd_sample_item(p, shm, item, wid_s, pass > 0))
      for (int pass = 0; pass < ((PROBE == 5 || PROBE == 10) ? 1 + ONE_RT : 1); ++pass) P2_LOOP(4 + 8 * pass, N_T4, attn_sample_item(p, shm, item, wid_s, pass > 0))
#undef P2_LOOP
    }
    xcd_barrier(xb, wid_s);

    { const int tid = tid_opaque(wid_s), wid = tid >> 6, lane = tid & 63; float* rstd = (float*)(ws + WS_SSQ);
      const float* sp = (const float*)(ws + WS_SQP2);
      for (int row = bid * 512 + tid; row < NPROMPT; row += G * 512) { float t = 0.f;
#pragma unroll
          for (int j = 0; j < 16; ++j) { const f32x4 v = *(const f32x4*)(sp + (size_t)row * 64 + 4 * j); t += (v[0] + v[1]) + (v[2] + v[3]); }
          rstd[row] = rsqrtf(t * (1.0f / 2048.0f) + EPS); }
      for (int row = NPROMPT + bid * 8 + wid; row < NTOK; row += G * 8) { const bf16_t* yr = (const bf16_t*)(ws + WS_PROJ) + (size_t)row * PC + C_SZ + lane * 8; float t = 0.f;
#pragma unroll
          for (int j = 0; j < 4; ++j) { const u32x4 v = *(const u32x4*)(yr + j * 512);
#pragma unroll
              for (int e = 0; e < 4; ++e) { const float a = __uint_as_float(v[e] << 16), c2 = __uint_as_float(v[e] & 0xffff0000u); t += a * a + c2 * c2; } }
#pragma unroll
          for (int o = 32; o > 0; o >>= 1) t += __shfl_xor(t, o);
          if (lane == 0) rstd[row] = rsqrtf(t * (1.0f / 2048.0f) + EPS); } }
    { SchedP3 S; S.proj = (const char*)(ws + WS_PROJ); S.wcat = (const char*)(ws + WS_WCAT); S.G = G; S.c = bid;
      EpiP3 E; E.part[0] = (bf16_t*)(ws + WS_H); E.part[1] = (bf16_t*)p.out; E.part[2] = (bf16_t*)p.out + (size_t)NTOK * 1024; E.part[3] = (bf16_t*)(ws + WS_PART3);
      for (int rep = 0; rep < (PROBE == 6 ? 1 + ONE_RT : 1); ++rep) { if (rep) grid.sync(); gemm_phase(lds3, 1024, PC, 4096, S, E, wid_s); } }
    xcd_barrier(xb, wid_s);

    { const int tid = tid_opaque(wid_s);
      bf16_t* p0 = (bf16_t*)(ws + WS_H); const bf16_t* p1 = (const bf16_t*)p.out; const bf16_t* p2 = p1 + (size_t)NTOK * 1024; const bf16_t* p3 = (const bf16_t*)(ws + WS_PART3);
      const bf16_t* proj = (const bf16_t*)(ws + WS_PROJ); const float* ssq = (const float*)(ws + WS_SSQ);
      const size_t n8 = (size_t)NTOK * 128;
#pragma unroll 2
      for (size_t i = (size_t)bid * 512 + tid; i < n8; i += (size_t)G * 512) {
          const size_t row = i >> 7; const int c8 = (int)(i & 127) * 8;
          const float rs = ssq[row];
          const u32x4 a0 = __builtin_nontemporal_load((const u32x4*)(p0 + i * 8)), a1 = __builtin_nontemporal_load((const u32x4*)(p1 + i * 8)), a2 = __builtin_nontemporal_load((const u32x4*)(p2 + i * 8)), a3 = __builtin_nontemporal_load((const u32x4*)(p3 + i * 8));
          const bf16_t* gp = proj + row * PC + C_G + c8;
          const u32x4 g0 = __builtin_nontemporal_load((const u32x4*)gp), g1 = __builtin_nontemporal_load((const u32x4*)(gp + 1024)), g2 = __builtin_nontemporal_load((const u32x4*)(gp + 2048));
          u32x4 o;
#pragma unroll
          for (int j = 0; j < 4; ++j) {
              const float lo = sigmoid_f(__uint_as_float(g0[j] << 16)) * __uint_as_float(a0[j] << 16) + sigmoid_f(__uint_as_float(g1[j] << 16)) * rs * (__uint_as_float(a1[j] << 16) + __uint_as_float(a2[j] << 16)) + sigmoid_f(__uint_as_float(g2[j] << 16)) * __uint_as_float(a3[j] << 16);
              const float hi = sigmoid_f(__uint_as_float(g0[j] & 0xffff0000u)) * __uint_as_float(a0[j] & 0xffff0000u) + sigmoid_f(__uint_as_float(g1[j] & 0xffff0000u)) * rs * (__uint_as_float(a1[j] & 0xffff0000u) + __uint_as_float(a2[j] & 0xffff0000u)) + sigmoid_f(__uint_as_float(g2[j] & 0xffff0000u)) * __uint_as_float(a3[j] & 0xffff0000u);
              o[j] = pack_bf2(lo, hi); }
          *(u32x4*)(p0 + i * 8) = o; } }
    xcd_barrier(xb, wid_s);

    { EpiP4 E; E.out = p.out; E.xp = p.in[0]; E.xs = p.in[1]; E.partq = (float*)(ws + WS_PART3);
      SchedP4 S; S.mg = (const char*)(ws + WS_H); S.wo = (const char*)(ws + WS_WO); S.G = G; S.c = bid;
      for (int rep = 0; rep < (PROBE == 6 ? 1 + ONE_RT : 1); ++rep) { if (rep) grid.sync(); gemm_phase(lds3, 1024, 1024, 1024, S, E, wid_s); } }
    xcd_barrier(xb, wid_s);

    { const int tid = tid_opaque(wid_s), wid = tid >> 6, lane = tid & 63;
#pragma unroll 2
    for (int row = bid * 8 + wid; row < NTOK; row += G * 8) {
        float* o = p.out + (size_t)row * 1024; const float* w = p.in[25];
        f32x4 v[4]; float ss = 0.f;
#pragma unroll
        for (int j = 0; j < 4; ++j) v[j] = __builtin_nontemporal_load((const f32x4*)(o + j * 256 + lane * 4));
        if (row >= 13312) { const float* pq = (const float*)(ws + WS_PART3) + (size_t)(row - 13312) * 256 + lane * 4;
#pragma unroll
            for (int kq = 0; kq < 3; ++kq) v[3] += *(const f32x4*)(pq + (size_t)kq * 4096 * 256); }
#pragma unroll
        for (int j = 0; j < 4; ++j) ss += v[j][0] * v[j][0] + v[j][1] * v[j][1] + v[j][2] * v[j][2] + v[j][3] * v[j][3];
#pragma unroll
        for (int of = 32; of > 0; of >>= 1) ss += __shfl_xor(ss, of);
        const float rs = rsqrtf(ss * (1.0f / 1024.0f) + EPS);
#pragma unroll
        for (int j = 0; j < 4; ++j) { const f32x4 wv = *(const f32x4*)(w + j * 256 + lane * 4); f32x4 r4 = v[j] * rs; r4 *= wv; __builtin_nontemporal_store(r4, (f32x4*)(o + j * 256 + lane * 4)); }
    } }
}

extern "C" void kernel_launch(void* const* d_in, const int* in_sizes, int n_in, void* d_out, int out_size, void* d_ws, size_t ws_size, hipStream_t stream) {
    static int grid_blocks = 0;
    if (grid_blocks == 0) {
        if (n_in != 26 || ws_size < WS_END) { fprintf(stderr, "kernel_launch: unexpected problem shape (n_in %d, ws %zu < %zu)\n", n_in, ws_size, (size_t)WS_END); grid_blocks = -1; return; }
        int dev = 0, cus = 0, per_cu = 0;
        hipGetDevice(&dev);
        hipDeviceGetAttribute(&cus, hipDeviceAttributeMultiprocessorCount, dev);
        if (hipFuncSetAttribute((const void*)mega, hipFuncAttributeMaxDynamicSharedMemorySize, LDS_BYTES) != hipSuccess) { fprintf(stderr, "kernel_launch: hipFuncSetAttribute failed\n"); grid_blocks = -1; return; }
        if (hipOccupancyMaxActiveBlocksPerMultiprocessor(&per_cu, (const void*)mega, 512, LDS_BYTES) != hipSuccess || per_cu < 1) { fprintf(stderr, "kernel_launch: occupancy query says %d\n", per_cu); per_cu = 1; }
        (void)hipGetLastError();
        grid_blocks = cus;
    }
    if (grid_blocks < 0) return;
    (void)hipMemsetAsync((unsigned char*)d_ws + WS_BAR, 0, 16384, stream);
    Params p{};
    for (int i = 0; i < 26; ++i) p.in[i] = (const float*)d_in[i];
    p.out = (float*)d_out; p.ws = (unsigned char*)d_ws;
    void* args[] = {&p};
    hipError_t e = hipLaunchCooperativeKernel((const void*)mega, dim3(grid_blocks), dim3(512), args, LDS_BYTES, stream);
    if (e != hipSuccess) fprintf(stderr, "cooperative launch failed: %s (grid %d)\n", hipGetErrorString(e), grid_blocks);
}
```

```cpp
#include <hip/hip_runtime.h>
#include <hip/hip_cooperative_groups.h>
#include <cstdio>
namespace cg = cooperative_groups;

#define DI __device__ __forceinline__
#define LAS __attribute__((address_space(3)))
typedef unsigned short bf16_t;
typedef short bf16x8 __attribute__((ext_vector_type(8)));
typedef float f32x2 __attribute__((ext_vector_type(2)));
typedef float f32x4 __attribute__((ext_vector_type(4)));
typedef float f32x16 __attribute__((ext_vector_type(16)));
typedef unsigned u32x2 __attribute__((ext_vector_type(2)));
typedef unsigned u32x4 __attribute__((ext_vector_type(4)));
typedef __bf16 bf16x2v __attribute__((ext_vector_type(2)));

constexpr int NTOK = 17408, NPROMPT = 16384;
constexpr int PC = 12288;
constexpr int C_PU = 0, C_PZ = 1024, C_SZ = 2048, C_XBC = 4096, C_Q = 7168, C_AZ = 8192, C_G = 9216;
constexpr int IN_COLS = 12320;
constexpr float EPS = 1e-6f;

constexpr size_t WS_PROJ = 0;
constexpr size_t WS_H    = WS_PROJ + (size_t)NTOK * PC * 2;
constexpr size_t WS_WIN  = WS_H + (size_t)NTOK * 1024 * 2;
constexpr size_t WS_WKV  = WS_WIN + (size_t)PC * 1024 * 2;
constexpr size_t WS_WCAT = WS_WKV + (size_t)2048 * 1024 * 2;
constexpr size_t WS_WO   = WS_WCAT + (size_t)1024 * 4096 * 2;
constexpr size_t WS_WPG  = WS_WO + (size_t)1024 * 1024 * 2;
constexpr size_t WS_MH   = WS_WPG + (size_t)4 * 256 * 256 * 2;
constexpr size_t WS_DT   = WS_MH + (size_t)2048 * 1024 * 2;
constexpr size_t WS_SSQ  = WS_DT + (size_t)NTOK * 32 * 4;
constexpr size_t WS_CTR  = WS_SSQ + (size_t)NTOK * 4;
constexpr size_t WS_PART3 = WS_CTR + 256;
constexpr size_t WS_SSQP = WS_PART3 + (size_t)NTOK * 1024 * 2;
constexpr size_t WS_BAR  = WS_SSQP + (1u << 20);
constexpr size_t WS_END  = WS_SSQP + (size_t)NTOK * 64 * 4;

constexpr size_t O_YP = 0, O_POOLP = 17825792, O_CONVP = 17948672, O_SSMP = 18022400, O_MK = 20119552, O_MV = 22216704,
                 O_POOLS = 24313856, O_CONVS = 26279936, O_SSMS = 27459584;

constexpr int LDS_BYTES = 147456;
constexpr int QSLOT_OFF = LDS_BYTES - 256;
#define ONE_RT (__builtin_amdgcn_readfirstlane(((volatile unsigned*)(p.ws + WS_CTR))[15] == 0u ? 1 : 0))
#define PROBE 0

struct Params { const float* in[26]; float* out; unsigned char* ws; };

DI float bf2f(bf16_t u) { return __uint_as_float(((unsigned)u) << 16); }
DI unsigned pack_bf2(float lo, float hi) { f32x2 v = {lo, hi}; bf16x2v b = __builtin_convertvector(v, bf16x2v); return __builtin_bit_cast(unsigned, b); }
DI bf16_t f2bf(float x) { return (bf16_t)(pack_bf2(x, 0.f) & 0xffffu); }
DI float silu_f(float x) { return x * __builtin_amdgcn_rcpf(1.f + __expf(-x)); }
DI float sigmoid_f(float x) { return __builtin_amdgcn_rcpf(1.f + __expf(-x)); }
DI int tid_opaque(int wid_s) { int t = wid_s * 64 + (int)__builtin_amdgcn_mbcnt_hi(~0u, __builtin_amdgcn_mbcnt_lo(~0u, 0u)); asm volatile("" : "+v"(t)); return t; }
DI void lds_barrier() { asm volatile("s_waitcnt lgkmcnt(0)" ::: "memory"); __builtin_amdgcn_s_barrier(); asm volatile("" ::: "memory"); }
DI float dpp_add_x1(float v) { return v + __builtin_bit_cast(float, __builtin_amdgcn_update_dpp(0, __builtin_bit_cast(int, v), 0xB1, 0xf, 0xf, false)); }
DI float dpp_add_x2(float v) { return v + __builtin_bit_cast(float, __builtin_amdgcn_update_dpp(0, __builtin_bit_cast(int, v), 0x4E, 0xf, 0xf, false)); }
DI float dpp_add_hm(float v) { return v + __builtin_bit_cast(float, __builtin_amdgcn_update_dpp(0, __builtin_bit_cast(int, v), 0x141, 0xf, 0xf, false)); }
DI float xchg32(float v, bool upper) { const unsigned u = __builtin_bit_cast(unsigned, v); auto r = __builtin_amdgcn_permlane32_swap(u, u, false, false); return __builtin_bit_cast(float, upper ? r[0] : r[1]); }
DI float xchg16(float v, bool odd) { const unsigned u = __builtin_bit_cast(unsigned, v); auto r = __builtin_amdgcn_permlane16_swap(u, u, false, false); return __builtin_bit_cast(float, odd ? r[0] : r[1]); }
DI float xchg8(float v) { return __builtin_bit_cast(float, __builtin_amdgcn_update_dpp(0, __builtin_bit_cast(int, v), 0x128, 0xf, 0xf, false)); }
DI float xchg_hm(float v) { return __builtin_bit_cast(float, __builtin_amdgcn_update_dpp(0, __builtin_bit_cast(int, v), 0x141, 0xf, 0xf, false)); }
DI int crow(int reg, int h) { return (reg & 3) + 8 * (reg >> 2) + 4 * h; }
#define MFMA32(a, b, c) __builtin_amdgcn_mfma_f32_32x32x16_bf16((a), (b), (c), 0, 0, 0)
DI const float* xrow(const Params& p, int row) { return row < NPROMPT ? p.in[0] + (size_t)row * 1024 : p.in[1] + (size_t)(row - NPROMPT) * 1024; }


#define XB_TMO      128
#define XB_XCNT(j)  (256  + 64 * (j))
#define XB_XSUB(j)  (1280 + 64 * (j))
#define XB_XGEN(j)  (2304 + 64 * (j))
#define XB_TOP      3328
#define XB_TOPGEN   3392
#define XCD_BAR_WORDS 3456
#define XB_SPIN_CAP (1u << 18)
DI unsigned xb_ld(unsigned* p)              { return __hip_atomic_load(p, __ATOMIC_RELAXED, __HIP_MEMORY_SCOPE_AGENT); }
DI unsigned xb_add(unsigned* p, unsigned v) { return __hip_atomic_fetch_add(p, v, __ATOMIC_RELAXED, __HIP_MEMORY_SCOPE_AGENT); }
DI unsigned xb_xcc_id() { return (unsigned)__builtin_amdgcn_s_getreg((3 << 11) | 20) & 0xFu; }
#define XB_SPIN(cond, bar) do { unsigned _sp = 0; while (cond) { __builtin_amdgcn_s_sleep(1); \
    if ((++_sp & 255u) == 0u) { if (xb_ld(&(bar)[XB_TMO])) break; if (_sp > XB_SPIN_CAP) { atomicAdd(&(bar)[XB_TMO], 1u); break; } } } } while (0)
struct XcdBarrier { unsigned* bar; unsigned x; volatile LAS unsigned* st; };
DI XcdBarrier xcd_barrier_post(unsigned* bar, volatile LAS unsigned* st, int wid_s) {
    XcdBarrier b; b.bar = bar; b.x = xb_xcc_id(); b.st = st;
    if (tid_opaque(wid_s) == 0) (void)xb_add(&bar[XB_XCNT(b.x)], 1u);
    return b;
}
DI void xcd_barrier_complete(unsigned* bar, unsigned x, unsigned& nloc, unsigned& nx) {
    const unsigned G = gridDim.x * gridDim.y * gridDim.z;
    unsigned sum, cnt, mine, sp = 0u;
    for (;;) {
        sum = 0u; cnt = 0u; mine = 0u;
#pragma unroll
        for (unsigned j = 0; j < 16; ++j) { const unsigned c = xb_ld(&bar[XB_XCNT(j)]); sum += c; cnt += (c > 0u) ? 1u : 0u; mine = (j == x) ? c : mine; }
        if (sum == G) break;
        __builtin_amdgcn_s_sleep(1);
        if ((++sp & 255u) == 0u) { if (xb_ld(&bar[XB_TMO])) break; if (sp > XB_SPIN_CAP) { atomicAdd(&bar[XB_TMO], 1u); break; } }
    }
    nloc = mine > 0u ? mine : 1u; nx = cnt > 0u ? cnt : 1u;
}
DI void xcd_barrier(const XcdBarrier& b, int wid_s) {
    asm volatile("s_waitcnt vmcnt(0)" ::: "memory");
    __syncthreads();
    if (tid_opaque(wid_s) == 0) {
        unsigned* bar = b.bar;
        __builtin_amdgcn_s_waitcnt(0);
        unsigned nloc = b.st[0], nx = b.st[1];
        if (nloc == 0u) { xcd_barrier_complete(bar, b.x, nloc, nx); b.st[0] = nloc; b.st[1] = nx; }
        const unsigned old = xb_add(&bar[XB_XSUB(b.x)], 1u);
        const unsigned gen = old / nloc;
        if (old + 1u == (gen + 1u) * nloc) {
            __builtin_amdgcn_fence(__ATOMIC_RELEASE, "agent");
            asm volatile("s_waitcnt vmcnt(0)" ::: "memory");
            const unsigned og = xb_add(&bar[XB_TOP], 1u);
            const unsigned tg = og / nx;
            if (og + 1u == (tg + 1u) * nx) xb_add(&bar[XB_TOPGEN], 1u);
            else XB_SPIN(xb_ld(&bar[XB_TOPGEN]) == tg, bar);
            __builtin_amdgcn_fence(__ATOMIC_ACQUIRE, "agent");
            xb_add(&bar[XB_XGEN(b.x)], 1u);
            asm volatile("s_waitcnt vmcnt(0)" ::: "memory");
        } else {
            XB_SPIN(xb_ld(&bar[XB_XGEN(b.x)]) == gen, bar);
            __builtin_amdgcn_fence(__ATOMIC_ACQUIRE, "agent");
            asm volatile("s_waitcnt vmcnt(0)" ::: "memory");
        }
    }
    __syncthreads();
}

constexpr int BM = 256, BK = 64, HALF = 128, HTB = HALF * BK * 2;
DI int lds_byte(int r, int c) { const int st = (r >> 4) * 2 + (c >> 5), rr = r & 15, cc = c & 31, ob = rr * 64 + cc * 2; return st * 1024 + (ob ^ (((ob >> 9) & 1) << 5)); }
DI void stage_rc(int b, int& R, int& C) { const int st = b / 1024, sb = b % 1024, swz = sb ^ (((sb >> 9) & 1) << 5); R = (st >> 1) * 16 + swz / 64; C = (st & 1) * 32 + (swz % 64) / 2; }
DI int perm32(int rho) { const int n = rho >> 4, i = rho & 15; return 8 * (i >> 2) + 4 * n + (i & 3); }
struct GUnit { const char* a; const char* b; int pm, pn, aux, nt; };

template <class Sched, class Epi>
DI void gemm_phase(LAS unsigned char* lds, const int K, const int lda, const int ldb, const Sched& S, const Epi& E, const int wid_s) {
    int tid_ = tid_opaque(wid_s);
    const int tid = tid_, wid = __builtin_amdgcn_readfirstlane(tid >> 6), lane = tid & 63, wr = wid >> 2, wc = wid & 3, fr = lane & 15, fq = lane >> 4;
    unsigned voffA[2], voffB[2];
#pragma unroll
    for (int i = 0; i < 2; ++i) { int R, C; stage_rc(tid * 16 + i * 8192, R, C); const int Rb = (R & ~31) + perm32(R & 31);
        voffA[i] = (unsigned)(R * lda + C) * 2u; voffB[i] = (unsigned)(Rb * ldb + C) * 2u; }
    const size_t kstep = (size_t)(BK * 2);
    const size_t hstepA = (size_t)HALF * lda * 2, hstepB = (size_t)HALF * ldb * 2;
    const unsigned ldsw = (unsigned)wid * 1024u;
    const int aoff = lds_byte(wr * 64 + fr, fq * 8), boff = lds_byte(wc * 32 + fr, fq * 8);
#define PG8_SA(b, h) (((b) * 2 + (h)) * HTB)
#define PG8_SB(b, h) ((4 + (b) * 2 + (h)) * HTB)
#define PG8_STAGE(bufoff, gbase, voff) do { _Pragma("unroll") for (int _i = 0; _i < 2; ++_i) \
        __builtin_amdgcn_global_load_lds((const unsigned*)((const char*)(gbase) + (voff)[_i]), (LAS unsigned*)(lds + (bufoff) + ldsw + _i * 8192), 16, 0, 0); } while (0)
#define PG8_LDA(dst, b, h) do { _Pragma("unroll") for (int m = 0; m < 4; ++m) _Pragma("unroll") for (int k = 0; k < 2; ++k) dst[m][k] = *(const LAS bf16x8*)(lds + PG8_SA(b, h) + aoff + m * 2048 + k * 1024); } while (0)
#define PG8_LDB(dst, b, h) do { _Pragma("unroll") for (int n = 0; n < 2; ++n) _Pragma("unroll") for (int k = 0; k < 2; ++k) dst[n][k] = *(const LAS bf16x8*)(lds + PG8_SB(b, h) + boff + n * 2048 + k * 1024); } while (0)
#define PG8_MMA(ai, bj, At, Bt) do { __builtin_amdgcn_s_setprio(1); _Pragma("unroll") for (int m = 0; m < 4; ++m) _Pragma("unroll") for (int n = 0; n < 2; ++n) _Pragma("unroll") for (int k = 0; k < 2; ++k) \
        acc[ai][bj][m][n] = __builtin_amdgcn_mfma_f32_16x16x32_bf16(Bt[n][k], At[m][k], acc[ai][bj][m][n], 0, 0, 0); __builtin_amdgcn_s_setprio(0); } while (0)
#define PG8_WAIT_V(n) asm volatile("s_waitcnt vmcnt(" #n ")" ::: "memory")
#define PG8_WAIT_L(n) asm volatile("s_waitcnt lgkmcnt(" #n ")" ::: "memory")
#define PG8_BAR __builtin_amdgcn_s_barrier()
#define PG8_SCHED __builtin_amdgcn_sched_barrier(0)
    GUnit cur, nxt; int ui = 0;
    if (!S.next(0, cur)) return;
    f32x4 acc[2][2][4][2];
#pragma unroll
    for (int a = 0; a < 2; ++a)
#pragma unroll
        for (int b = 0; b < 2; ++b)
#pragma unroll
            for (int m = 0; m < 4; ++m)
#pragma unroll
                for (int n = 0; n < 2; ++n) acc[a][b][m][n] = (f32x4){0.f, 0.f, 0.f, 0.f};
    bf16x8 At[4][2], B0[2][2], B1[2][2];
    const char* cA = cur.a; const char* cB = cur.b;
    PG8_STAGE(PG8_SB(0, 0), cB, voffB); PG8_STAGE(PG8_SA(0, 0), cA, voffA); PG8_STAGE(PG8_SB(0, 1), cB + hstepB, voffB); PG8_STAGE(PG8_SA(0, 1), cA + hstepA, voffA);
    if (wr == 1) PG8_BAR;
    PG8_WAIT_V(4); PG8_BAR;
    PG8_STAGE(PG8_SB(1, 0), cB + kstep, voffB); PG8_STAGE(PG8_SA(1, 0), cA + kstep, voffA); PG8_STAGE(PG8_SB(1, 1), cB + hstepB + kstep, voffB);
    PG8_WAIT_V(6); PG8_BAR;
    for (;;) {
        const bool has_next = S.next(ui + 1, nxt);
        const char* nA = has_next ? nxt.a : cA; const char* nB = has_next ? nxt.b : cB;
        const int nt = cur.nt;
        for (int t = 0; t < nt; t += 2) {
            const bool last = (t == nt - 2);
            const char* a1 = cA + (size_t)(t + 1) * kstep;
            const char* a2 = last ? nA : cA + (size_t)(t + 2) * kstep; const char* b2 = last ? nB : cB + (size_t)(t + 2) * kstep;
            const char* a3 = a2 + kstep; const char* b3 = b2 + kstep;
            PG8_LDB(B0, 0, 0); PG8_SCHED; PG8_LDA(At, 0, 0); PG8_STAGE(PG8_SA(1, 1), a1 + hstepA, voffA);
            PG8_WAIT_L(8); PG8_BAR; PG8_WAIT_L(0); PG8_MMA(0, 0, At, B0); PG8_BAR; PG8_SCHED;
            PG8_LDB(B1, 0, 1); PG8_STAGE(PG8_SB(0, 0), b2, voffB);
            PG8_BAR; PG8_WAIT_L(0); PG8_MMA(0, 1, At, B1); PG8_BAR;
            PG8_LDA(At, 0, 1); PG8_STAGE(PG8_SA(0, 0), a2, voffA);
            PG8_BAR; PG8_WAIT_L(0); PG8_MMA(1, 0, At, B0); PG8_BAR; PG8_SCHED;
            PG8_STAGE(PG8_SB(0, 1), b2 + hstepB, voffB);
            PG8_WAIT_V(6); PG8_BAR; PG8_MMA(1, 1, At, B1); PG8_BAR;
            PG8_LDB(B0, 1, 0); PG8_SCHED; PG8_LDA(At, 1, 0); PG8_STAGE(PG8_SA(0, 1), a2 + hstepA, voffA);
            PG8_WAIT_L(8); PG8_BAR; PG8_WAIT_L(0); PG8_MMA(0, 0, At, B0); PG8_BAR; PG8_SCHED;
            PG8_LDB(B1, 1, 1); PG8_STAGE(PG8_SB(1, 0), b3, voffB);
            PG8_BAR; PG8_WAIT_L(0); PG8_MMA(0, 1, At, B1); PG8_BAR;
            PG8_LDA(At, 1, 1); PG8_STAGE(PG8_SA(1, 0), a3, voffA);
            PG8_BAR; PG8_WAIT_L(0); PG8_MMA(1, 0, At, B0); PG8_BAR; PG8_SCHED;
            PG8_STAGE(PG8_SB(1, 1), b3 + hstepB, voffB);
            PG8_WAIT_V(6); PG8_BAR; PG8_MMA(1, 1, At, B1); PG8_BAR;
        }
        E(acc, cur, wr, wc, fr, fq);
        if (!has_next) break;
#pragma unroll
        for (int a = 0; a < 2; ++a)
#pragma unroll
            for (int b = 0; b < 2; ++b)
#pragma unroll
                for (int m = 0; m < 4; ++m)
#pragma unroll
                    for (int n = 0; n < 2; ++n) acc[a][b][m][n] = (f32x4){0.f, 0.f, 0.f, 0.f};
        cur = nxt; cA = nA; cB = nB; ++ui;
    }
    PG8_WAIT_V(0);
    if (wr == 0) PG8_BAR;
    PG8_BAR;
#undef PG8_SA
#undef PG8_SB
#undef PG8_STAGE
#undef PG8_LDA
#undef PG8_LDB
#undef PG8_MMA
#undef PG8_WAIT_V
#undef PG8_WAIT_L
#undef PG8_BAR
#undef PG8_SCHED
}

struct SchedP1 {
    const char* h; const char* win; const char* mh; const char* wkv; int G, c;
    DI bool next(int i, GUnit& u) const {
        const int L = i * G + c;
        if (L >= 3328) return false;
        if (L < 3264) {
            const int nM = 68, nN = 48, nwg = 3264; int wgid = L;
            { const int q = nwg / 8, r = nwg % 8, xcd = wgid % 8, off = wgid / 8; wgid = (xcd < r ? xcd * (q + 1) : r * (q + 1) + (xcd - r) * q) + off; }
            const int nig = 8 * nN, gid = wgid / nig, fm = gid * 8, gsz = (nM - fm) < 8 ? (nM - fm) : 8;
            u.pm = fm + ((wgid % nig) % gsz); u.pn = (wgid % nig) / gsz; u.aux = 0; u.nt = 16;
            u.a = h + (size_t)u.pm * 256 * 1024 * 2; u.b = win + (size_t)u.pn * 256 * 1024 * 2;
        } else {
            const int idx = L - 3264; u.pm = idx >> 3; u.pn = idx & 7; u.aux = 1; u.nt = 16;
            u.a = mh + (size_t)u.pm * 256 * 1024 * 2; u.b = wkv + (size_t)u.pn * 256 * 1024 * 2;
        }
        return true;
    }
};
struct SchedP3 {
    const char* proj; const char* wcat; int G, c;
    DI bool next(int i, GUnit& u) const {
        const int L = i * G + c;
        if (L >= 1088) return false;
        const int part = L / 272, tile = L % 272; u.pm = tile % 68; u.pn = tile / 68; u.aux = part; u.nt = 16;
        const int acol = part == 0 ? C_PZ : (part == 1 ? C_SZ : (part == 2 ? C_SZ + 1024 : C_Q));
        u.a = proj + ((size_t)u.pm * 256 * PC + acol) * 2; u.b = wcat + ((size_t)u.pn * 256 * 4096 + part * 1024) * 2;
        return true;
    }
};
struct SchedP4 {
    const char* mg; const char* wo; int G, c;
    DI bool next(int i, GUnit& u) const {
        const int L = i * G + c;
        if (L >= 320) return false;
        if (L < 256) { u.pm = L % 68; u.pn = L / 68; u.aux = 0; u.nt = 16;
            u.a = mg + ((size_t)u.pm * 256 * 1024) * 2; u.b = wo + ((size_t)u.pn * 256 * 1024) * 2; }
        else { const int q = L - 256, tile = 256 + (q >> 2), kq = q & 3; u.pm = tile % 68; u.pn = tile / 68; u.aux = kq; u.nt = 4;
            u.a = mg + ((size_t)u.pm * 256 * 1024 + kq * 256) * 2; u.b = wo + ((size_t)u.pn * 256 * 1024 + kq * 256) * 2; }
        return true;
    }
};

struct EpiP1 {
    bf16_t* proj; float* out;
    DI void operator()(const f32x4 (&acc)[2][2][4][2], const GUnit& u, int wr, int wc, int fr, int fq) const {
        const int row0 = u.pm * 256 + wr * 64 + fr, col0 = u.pn * 256 + wc * 32 + 8 * fq;
        if (u.aux == 0) {
            const int cb = u.pn * 256;
            const int act = (cb >= C_G) ? 0 : (((cb >= C_PZ && cb < C_XBC) || (cb >= C_AZ)) ? 1 : 0);
#pragma unroll
            for (int ai = 0; ai < 2; ++ai)
#pragma unroll
                for (int m = 0; m < 4; ++m) { bf16_t* rowp = proj + (size_t)(row0 + ai * HALF + m * 16) * PC + col0;
#pragma unroll
                    for (int bj = 0; bj < 2; ++bj) { f32x4 v0 = acc[ai][bj][m][0], v1 = acc[ai][bj][m][1];
                        if (act == 1) {
#pragma unroll
                            for (int j = 0; j < 4; ++j) { v0[j] = silu_f(v0[j]); v1[j] = silu_f(v1[j]); } }
                        else if (act == 2) {
#pragma unroll
                            for (int j = 0; j < 4; ++j) { v0[j] = sigmoid_f(v0[j]); v1[j] = sigmoid_f(v1[j]); } }
                        u32x4 w; w.x = pack_bf2(v0[0], v0[1]); w.y = pack_bf2(v0[2], v0[3]); w.z = pack_bf2(v1[0], v1[1]); w.w = pack_bf2(v1[2], v1[3]);
                        __builtin_nontemporal_store(w, (u32x4*)(rowp + bj * HALF)); } }
        } else {
            float* base = out + (col0 < 1024 ? O_MK : O_MV); const int c = col0 & 1023;
#pragma unroll
            for (int ai = 0; ai < 2; ++ai)
#pragma unroll
                for (int m = 0; m < 4; ++m) { float* rowp = base + (size_t)(row0 + ai * HALF + m * 16) * 1024 + c;
#pragma unroll
                    for (int bj = 0; bj < 2; ++bj) { *(f32x4*)(rowp + bj * HALF) = acc[ai][bj][m][0]; *(f32x4*)(rowp + bj * HALF + 4) = acc[ai][bj][m][1]; } }
        }
    }
};
struct EpiP3 {
    bf16_t* part[4];
    DI void operator()(const f32x4 (&acc)[2][2][4][2], const GUnit& u, int wr, int wc, int fr, int fq) const {
        const int row0 = u.pm * 256 + wr * 64 + fr, col0 = u.pn * 256 + wc * 32 + 8 * fq;
        bf16_t* base = u.aux == 0 ? part[0] : (u.aux == 1 ? part[1] : (u.aux == 2 ? part[2] : part[3]));
#pragma unroll
        for (int ai = 0; ai < 2; ++ai)
#pragma unroll
            for (int m = 0; m < 4; ++m) { bf16_t* rowp = base + (size_t)(row0 + ai * HALF + m * 16) * 1024 + col0;
#pragma unroll
                for (int bj = 0; bj < 2; ++bj) { const f32x4 v0 = acc[ai][bj][m][0], v1 = acc[ai][bj][m][1];
                    u32x4 w; w.x = pack_bf2(v0[0], v0[1]); w.y = pack_bf2(v0[2], v0[3]); w.z = pack_bf2(v1[0], v1[1]); w.w = pack_bf2(v1[2], v1[3]);
                    *(u32x4*)(rowp + bj * HALF) = w; } }
    }
};
struct EpiP4 {
    float* out; const float* xp; const float* xs; float* partq;
    DI void operator()(const f32x4 (&acc)[2][2][4][2], const GUnit& u, int wr, int wc, int fr, int fq) const {
        const int row0 = u.pm * 256 + wr * 64 + fr, col0 = u.pn * 256 + wc * 32 + 8 * fq;
#pragma unroll
        for (int ai = 0; ai < 2; ++ai)
#pragma unroll
            for (int m = 0; m < 4; ++m) { const int row = row0 + ai * HALF + m * 16;
                if (u.aux == 0) {
                    const float* xr = (row < NPROMPT ? xp + (size_t)row * 1024 : xs + (size_t)(row - NPROMPT) * 1024) + col0;
                    float* o = out + (size_t)row * 1024 + col0;
#pragma unroll
                    for (int bj = 0; bj < 2; ++bj) { *(f32x4*)(o + bj * HALF) = __builtin_nontemporal_load((const f32x4*)(xr + bj * HALF)) + acc[ai][bj][m][0]; *(f32x4*)(o + bj * HALF + 4) = __builtin_nontemporal_load((const f32x4*)(xr + bj * HALF + 4)) + acc[ai][bj][m][1]; }
                } else {
                    float* o = partq + ((size_t)(u.aux - 1) * 4096 + (row - 13312)) * 256 + (col0 - 768);
#pragma unroll
                    for (int bj = 0; bj < 2; ++bj) { *(f32x4*)(o + bj * HALF) = acc[ai][bj][m][0]; *(f32x4*)(o + bj * HALF + 4) = acc[ai][bj][m][1]; }
                } }
    }
};

DI bf16x8 tr_frag(const bf16_t* arr, int stride_elems, int k0, int c0, int lane) {
    const int h = lane >> 5, blk = (lane >> 4) & 1, q = (lane & 15) >> 2, pp = lane & 3;
    const unsigned a0 = (unsigned)(size_t)(arr + (k0 + 8 * h + q) * stride_elems + c0 + 16 * blk + 4 * pp);
    const unsigned a1 = a0 + 4u * (unsigned)stride_elems * 2u;
    u32x2 lo, hi;
    asm volatile("ds_read_b64_tr_b16 %0, %2\n\tds_read_b64_tr_b16 %1, %3\n\ts_waitcnt lgkmcnt(0)" : "=&v"(lo), "=&v"(hi) : "v"(a0), "v"(a1) : "memory");
    u32x4 w; w.x = lo.x; w.y = lo.y; w.z = hi.x; w.w = hi.y;
    return __builtin_bit_cast(bf16x8, w);
}
DI void tr_tile_wave(const float* src, int srcld, int srccol0, int k0, bf16_t* dst, int dstld, const float* kscale, float mul, bf16_t* tl, int lane) {
    const int kq = lane >> 4, n4 = (lane & 15) * 4;
    f32x4 v[16];
#pragma unroll
    for (int it = 0; it < 16; ++it) v[it] = __builtin_nontemporal_load((const f32x4*)(src + (size_t)(k0 + it * 4 + kq) * srcld + srccol0 + n4));
#pragma unroll
    for (int it = 0; it < 16; ++it) { const int k = it * 4 + kq; const float sc = (kscale ? kscale[k0 + k] : 1.0f) * mul;
        u32x2 w; w.x = pack_bf2(v[it][0] * sc, v[it][1] * sc); w.y = pack_bf2(v[it][2] * sc, v[it][3] * sc);
        *(u32x2*)(tl + k * 72 + n4) = w; }
    asm volatile("s_waitcnt lgkmcnt(0)" ::: "memory");
    const int r = lane & 31, h = lane >> 5;
#pragma unroll
    for (int c = 0; c < 2; ++c)
#pragma unroll
        for (int ks = 0; ks < 4; ++ks) { const bf16x8 f = tr_frag(tl, 72, ks * 16, c * 32, lane);
            *(bf16x8*)(dst + (size_t)(c * 32 + r) * dstld + k0 + ks * 16 + 8 * h) = f; }
}

DI void phase0(const Params& p, unsigned char* lds, const int wid_s) {
    const int tid = tid_opaque(wid_s), wid = tid >> 6, lane = tid & 63, G = gridDim.x, bid = blockIdx.x;
    unsigned char* ws = p.ws;
    if (bid == 0 && tid < 16) ((unsigned*)(ws + WS_CTR))[tid] = 0u;
    const int rank = wid * G + bid, NWK = 8 * G;
    bf16_t* tl = (bf16_t*)(lds + wid * 9216);
    for (int t = rank; t < 4944; t += NWK) {
        if (t >= 4928) { const int kt = t - 4928;
            tr_tile_wave(p.in[9], IN_COLS, 7168, kt * 64, (bf16_t*)(ws + WS_SSQP), 1024, nullptr, 1.0f, tl, lane); }
        else if (t < 3072) { const int nt_ = t >> 4, kt = t & 15; const int n0 = nt_ * 64; const int sc0 = n0 < C_Q ? n0 : n0 + 32;
            tr_tile_wave(p.in[9], IN_COLS, sc0, kt * 64, (bf16_t*)(ws + WS_WIN) + (size_t)n0 * 1024, 1024, nullptr, (n0 >= C_Q && n0 < C_AZ) ? 0.0625f : 1.0f, tl, lane); }
        else if (t < 3584) { const int u = t - 3072; const int nt_ = u >> 4, kt = u & 15; const int n0 = nt_ * 64;
            tr_tile_wave(n0 < 1024 ? p.in[19] : p.in[20], 1024, n0 & 1023, kt * 64, (bf16_t*)(ws + WS_WKV) + (size_t)n0 * 1024, 1024, nullptr, 1.0f, tl, lane); }
        else if (t < 4608) { const int u = t - 3584; const int nt_ = u >> 6, kt = u & 63; const int n0 = nt_ * 64, k0 = kt * 64;
            bf16_t* dst = (bf16_t*)(ws + WS_WCAT) + (size_t)n0 * 4096;
            if (k0 < 1024) tr_tile_wave(p.in[21], 1024, n0, k0, dst, 4096, nullptr, 1.0f, tl, lane);
            else if (k0 < 3072) tr_tile_wave(p.in[22], 1024, n0, k0 - 1024, dst + 1024, 4096, p.in[17], 1.0f, tl, lane);
            else tr_tile_wave(p.in[23], 1024, n0, k0 - 3072, dst + 3072, 4096, nullptr, 1.0f, tl, lane); }
        else if (t < 4864) { const int u = t - 4608; const int nt_ = u >> 4, kt = u & 15;
            tr_tile_wave(p.in[24], 1024, nt_ * 64, kt * 64, (bf16_t*)(ws + WS_WO) + (size_t)nt_ * 64 * 1024, 1024, nullptr, 1.0f, tl, lane); }
        else { const int u = t - 4864; const int g = u >> 4, nt_ = (u >> 2) & 3, kt = u & 3;
            tr_tile_wave(p.in[10] + (size_t)g * 65536, 256, nt_ * 64, kt * 64, (bf16_t*)(ws + WS_WPG) + (size_t)g * 65536 + (size_t)nt_ * 64 * 256, 256, nullptr, 1.0f, tl, lane); }
    }
    for (int row = rank; row < NTOK + 2048; row += NWK) {
        const float* src; const float* w; bf16_t* dst;
        if (row < NTOK) { src = xrow(p, row); w = p.in[8]; dst = (bf16_t*)(ws + WS_H) + (size_t)row * 1024; }
        else { src = p.in[2] + (size_t)(row - NTOK) * 1024; w = p.in[18]; dst = (bf16_t*)(ws + WS_MH) + (size_t)(row - NTOK) * 1024; }
        f32x4 v[4]; float ss = 0.f;
#pragma unroll
        for (int j = 0; j < 4; ++j) { v[j] = __builtin_nontemporal_load((const f32x4*)(src + j * 256 + lane * 4)); ss += v[j][0] * v[j][0] + v[j][1] * v[j][1] + v[j][2] * v[j][2] + v[j][3] * v[j][3]; }
#pragma unroll
        for (int o = 32; o > 0; o >>= 1) ss += __shfl_xor(ss, o);
        const float rs = rsqrtf(ss * (1.0f / 1024.0f) + EPS);
#pragma unroll
        for (int j = 0; j < 4; ++j) { const f32x4 wv = *(const f32x4*)(w + j * 256 + lane * 4);
            u32x2 o2; o2.x = pack_bf2(v[j][0] * rs * wv[0], v[j][1] * rs * wv[1]); o2.y = pack_bf2(v[j][2] * rs * wv[2], v[j][3] * rs * wv[3]);
            *(u32x2*)(dst + j * 256 + lane * 4) = o2; }
    }
}

#define SSD_DRY (PROBE == 3 && ((volatile int*)(lds + QSLOT_OFF))[1] != 0)
#define SSD_LVL ((PROBE == 3) ? ((volatile int*)(lds + QSLOT_OFF))[1] : 0)
#ifndef PROBE_LVL
#define PROBE_LVL 1
#endif
DI void ssd_prompt_item(const Params& p, unsigned char* lds, int item, const int wid_s) {
    const int tid = tid_opaque(wid_s), wid = tid >> 6, lane = tid & 63, r = lane & 31, hh = lane >> 5;
    const int b = item >> 5, head = item & 31, g = head >> 3;
    bf16_t* proj = (bf16_t*)(p.ws + WS_PROJ);
    const bf16_t* bcb = (const bf16_t*)(p.ws + WS_PART3);
    const float* dtbuf = (const float*)(p.ws + WS_DT);
    const float Ah = -__expf(p.in[15][head]);
    const float Dh = p.in[16][head];
    const float* convw = p.in[12]; const float* convb = p.in[13];
    bf16_t* Cs = (bf16_t*)lds;
    bf16_t* Bs = Cs + 128 * 136;
    bf16_t* Ms = Bs + 128 * 136;
    bf16_t* xs = Ms + 128 * 136;
    bf16_t* hb = xs + 128 * 72;
    float* acs = (float*)(hb + 64 * 136);
    float* wk = acs + 128; float* dtv = wk + 128; float* eacs = dtv + 128; float* cw = eacs + 128;
    f32x16 hacc; for (int i = 0; i < 16; ++i) hacc[i] = 0.f;
    const int pt = wid >> 2, ntl = wid & 3;
    const int qt = wid >> 1, t2 = wid & 1;
    const int j0 = wid, j1 = 8 + wid;
    const int gq0 = j0 < 1 ? 0 : (j0 < 3 ? 1 : (j0 < 6 ? 2 : 3)), gk0 = j0 - gq0 * (gq0 + 1) / 2;
    const int gq1 = 3, gk1 = j1 - 6;
    const bool two = wid < 2;
    const int xpair = tid & 31, xseg = tid >> 5;
    const int xch = head * 64 + 2 * xpair;
    if (tid < 64) {
#pragma unroll
        for (int k = 0; k < 4; ++k) cw[k * 64 + tid] = convw[k * 3072 + head * 64 + tid];
        cw[4 * 64 + tid] = convb[head * 64 + tid]; }
    const unsigned roff0 = (unsigned)(b * 2048 + xseg * 8 - 3) * PC + C_XBC + xch;
    const unsigned boff0 = (unsigned)(b * 2048 + (tid >> 5)) * 1024 + g * 128 + ((tid & 31) >> 4) * 512 + (tid & 15) * 8;
    const unsigned zoff0 = (unsigned)(b * 2048 + qt * 32 + r) * PC + C_SZ + head * 64 + t2 * 32 + 4 * hh;
    unsigned raw[11]; u32x4 bcv[8]; u32x2 zr[4]; float dtc0 = 0.f, dtc1 = 0.f;
#pragma unroll
    for (int i = 0; i < 11; ++i) { const int t = xseg * 8 - 3 + i; raw[i] = (t >= 0) ? *(const unsigned*)(proj + (roff0 + (unsigned)(i * PC))) : 0u; }
#pragma unroll
    for (int j = 0; j < 8; ++j) bcv[j] = *(const u32x4*)(bcb + (boff0 + (unsigned)(j * 16 * 1024)));
#pragma unroll
    for (int gq = 0; gq < 4; ++gq) zr[gq] = *(const u32x2*)(proj + (zoff0 + (unsigned)(8 * gq)));
    if (wid == 0) { dtc0 = dtbuf[(size_t)(b * 2048 + 2 * lane) * 32 + head]; dtc1 = dtbuf[(size_t)(b * 2048 + 2 * lane + 1) * 32 + head]; }
    lds_barrier();
    for (int c = 0; c < 16; ++c) {
        const int R0 = b * 2048 + c * 128;
        if (wid == 0) {
            const float a0 = dtc0 * Ah, a1 = dtc1 * Ah; float s = a0 + a1;
#define SCAN_DPP(ctrl, rmask) s += __builtin_bit_cast(float, __builtin_amdgcn_update_dpp(0, __builtin_bit_cast(int, s), (ctrl), (rmask), 0xf, false))
            SCAN_DPP(0x111, 0xf); SCAN_DPP(0x112, 0xf); SCAN_DPP(0x114, 0xf); SCAN_DPP(0x118, 0xf); SCAN_DPP(0x142, 0xa); SCAN_DPP(0x143, 0xc);
#undef SCAN_DPP
            const float tot = __shfl(s, 63); const float s0 = s - a1;
            acs[2 * lane] = s0; acs[2 * lane + 1] = s; wk[2 * lane] = dtc0 * __expf(tot - s0); wk[2 * lane + 1] = dtc1 * __expf(tot - s);
            dtv[2 * lane] = dtc0; dtv[2 * lane + 1] = dtc1; eacs[2 * lane] = __expf(s0); eacs[2 * lane + 1] = __expf(s);
            if (c < 15) { dtc0 = dtbuf[(size_t)(R0 + 128 + 2 * lane) * 32 + head]; dtc1 = dtbuf[(size_t)(R0 + 128 + 2 * lane + 1) * 32 + head]; }
        }
        {
            float w0[4], w1[4];
#pragma unroll
            for (int k = 0; k < 4; ++k) { const f32x2 t = *(const f32x2*)(cw + k * 64 + 2 * xpair); w0[k] = t[0]; w1[k] = t[1]; }
            const f32x2 bt = *(const f32x2*)(cw + 4 * 64 + 2 * xpair); const float b0 = bt[0], b1 = bt[1];
#pragma unroll
            for (int i = 0; i < 8; ++i) {
                float o0 = b0, o1 = b1;
#pragma unroll
                for (int k = 0; k < 4; ++k) { o0 += w0[k] * __uint_as_float(raw[i + k] << 16); o1 += w1[k] * __uint_as_float(raw[i + k] & 0xffff0000u); }
                o0 = silu_f(o0); o1 = silu_f(o1);
                const int k = xseg * 8 + i;
                *(unsigned*)(xs + k * 72 + 2 * xpair) = pack_bf2(o0, o1);
            }
#pragma unroll
            for (int j = 0; j < 8; ++j) { const int id = tid + 512 * j, row = id >> 5, part = id & 31;
                if (part < 16) *(u32x4*)(Bs + row * 136 + part * 8) = bcv[j]; else *(u32x4*)(Cs + row * 136 + (part - 16) * 8) = bcv[j]; }
        }
        lds_barrier();
        f32x16 yoff;
        for (int i = 0; i < 16; ++i) yoff[i] = 0.f;
        if (c > 0) {
#pragma unroll
            for (int kk = 0; kk < 8; ++kk) { const bf16x8 a = *(const bf16x8*)(Cs + (qt * 32 + r) * 136 + kk * 16 + 8 * hh); const bf16x8 bb = *(const bf16x8*)(hb + (t2 * 32 + r) * 136 + kk * 16 + 8 * hh);
                yoff = MFMA32(bb, a, yoff); } }
        for (int job = 0; job < (two ? 2 : 1); ++job) {
            const int gq = job ? gq1 : gq0, gk = job ? gk1 : gk0;
            f32x16 ga; for (int i = 0; i < 16; ++i) ga[i] = 0.f;
#pragma unroll
            for (int kk = 0; kk < 8; ++kk) { const bf16x8 a = *(const bf16x8*)(Cs + (gq * 32 + r) * 136 + kk * 16 + 8 * hh); const bf16x8 bb = *(const bf16x8*)(Bs + (gk * 32 + r) * 136 + kk * 16 + 8 * hh);
                ga = MFMA32(bb, a, ga); }
            const int q = gq * 32 + r; const float aq = acs[q];
#pragma unroll
            for (int g4 = 0; g4 < 4; ++g4) { const int k4 = gk * 32 + 8 * g4 + 4 * hh; const f32x4 ak = *(const f32x4*)(acs + k4), dk = *(const f32x4*)(dtv + k4);
                float v[4];
#pragma unroll
                for (int j = 0; j < 4; ++j) v[j] = (k4 + j <= q) ? ga[4 * g4 + j] * __expf(aq - ak[j]) * dk[j] : 0.f;
                u32x2 o; o.x = pack_bf2(v[0], v[1]); o.y = pack_bf2(v[2], v[3]); *(u32x2*)(Ms + q * 136 + k4) = o; }
        }
        lds_barrier();
        {
            f32x16 yd; for (int i = 0; i < 16; ++i) yd[i] = 0.f;
#pragma unroll
            for (int kk = 0; kk < 8; ++kk) if (kk < 2 * (qt + 1)) { const bf16x8 a = *(const bf16x8*)(Ms + (qt * 32 + r) * 136 + kk * 16 + 8 * hh); const bf16x8 bb = tr_frag(xs, 72, kk * 16, t2 * 32, lane);
                yd = MFMA32(bb, a, yd); }
            const int q = qt * 32 + r; const float eq = eacs[q];
            unsigned zo = zoff0 + (unsigned)(c * 128 * PC); asm volatile("" : "+v"(zo));
#pragma unroll
            for (int gq = 0; gq < 4; ++gq) { const int p4 = t2 * 32 + 8 * gq + 4 * hh;
                const u32x2 xv = *(const u32x2*)(xs + q * 72 + p4); const u32x2 z = zr[gq];
                const float y0 = eq * yoff[4 * gq] + yd[4 * gq] + Dh * __uint_as_float(xv.x << 16), y1 = eq * yoff[4 * gq + 1] + yd[4 * gq + 1] + Dh * __uint_as_float(xv.x & 0xffff0000u);
                const float y2 = eq * yoff[4 * gq + 2] + yd[4 * gq + 2] + Dh * __uint_as_float(xv.y << 16), y3 = eq * yoff[4 * gq + 3] + yd[4 * gq + 3] + Dh * __uint_as_float(xv.y & 0xffff0000u);
                u32x2 o; o.x = pack_bf2(y0 * __uint_as_float(z.x << 16), y1 * __uint_as_float(z.x & 0xffff0000u)); o.y = pack_bf2(y2 * __uint_as_float(z.y << 16), y3 * __uint_as_float(z.y & 0xffff0000u));
                if (!SSD_DRY) *(u32x2*)(proj + (zo + (unsigned)(8 * gq))) = o; }
            if (c < 15) { zo += (unsigned)(128 * PC);
#pragma unroll
                for (int gq = 0; gq < 4; ++gq) zr[gq] = *(const u32x2*)(proj + (zo + (unsigned)(8 * gq))); }
        }
        if (c < 15) {
            unsigned ro = roff0 + (unsigned)((c + 1) * 128 * PC); asm volatile("" : "+v"(ro));
#pragma unroll
            for (int i = 0; i < 11; ++i) raw[i] = *(const unsigned*)(proj + (ro + (unsigned)(i * PC)));
            unsigned bo = boff0 + (unsigned)((c + 1) * 128 * 1024); asm volatile("" : "+v"(bo));
#pragma unroll
            for (int j = 0; j < 8; ++j) bcv[j] = *(const u32x4*)(bcb + (bo + (unsigned)(j * 16 * 1024)));
        }
        {
            const float cd = eacs[127];
#pragma unroll
            for (int i = 0; i < 16; ++i) hacc[i] *= cd;
#pragma unroll
            for (int kk = 0; kk < 8; ++kk) { const u32x4 xa = __builtin_bit_cast(u32x4, tr_frag(xs, 72, kk * 16, pt * 32, lane)); const bf16x8 bb = tr_frag(Bs, 136, kk * 16, ntl * 32, lane);
                const f32x4 wa = *(const f32x4*)(wk + kk * 16 + 8 * hh), wb = *(const f32x4*)(wk + kk * 16 + 8 * hh + 4);
                u32x4 xsc; xsc.x = pack_bf2(__uint_as_float(xa.x << 16) * wa[0], __uint_as_float(xa.x & 0xffff0000u) * wa[1]); xsc.y = pack_bf2(__uint_as_float(xa.y << 16) * wa[2], __uint_as_float(xa.y & 0xffff0000u) * wa[3]);
                xsc.z = pack_bf2(__uint_as_float(xa.z << 16) * wb[0], __uint_as_float(xa.z & 0xffff0000u) * wb[1]); xsc.w = pack_bf2(__uint_as_float(xa.w << 16) * wb[2], __uint_as_float(xa.w & 0xffff0000u) * wb[3]);
                hacc = MFMA32(bb, __builtin_bit_cast(bf16x8, xsc), hacc); }
#pragma unroll
            for (int g4 = 0; g4 < 4; ++g4) { u32x2 o; o.x = pack_bf2(hacc[4 * g4], hacc[4 * g4 + 1]); o.y = pack_bf2(hacc[4 * g4 + 2], hacc[4 * g4 + 3]);
                *(u32x2*)(hb + (pt * 32 + r) * 136 + ntl * 32 + 8 * g4 + 4 * hh) = o; }
        }
        lds_barrier();
    }
    float* so = p.out + O_SSMP + (size_t)(b * 32 + head) * 8192;
#pragma unroll
    for (int g4 = 0; g4 < 4; ++g4) if (!SSD_DRY) *(f32x4*)(so + (pt * 32 + r) * 128 + ntl * 32 + 8 * g4 + 4 * hh) = (f32x4){hacc[4 * g4], hacc[4 * g4 + 1], hacc[4 * g4 + 2], hacc[4 * g4 + 3]};
}

DI void bc_conv_pass(const Params& p, const int wid_s) {
    const int tid = tid_opaque(wid_s), G = gridDim.x, bid = blockIdx.x;
    { const int wid = tid >> 6, lane = tid & 63, r = lane & 31, hh = lane >> 5;
      for (int T = bid + G * wid; T < NTOK / 32; T += G * 8) {
          const bf16_t* ap = (const bf16_t*)(p.ws + WS_H) + (size_t)(T * 32 + r) * 1024 + 8 * hh;
          const bf16_t* bp = (const bf16_t*)(p.ws + WS_SSQP) + (size_t)r * 1024 + 8 * hh;
          f32x16 acc; for (int i = 0; i < 16; ++i) acc[i] = 0.f;
#pragma unroll 8
          for (int kk = 0; kk < 64; ++kk) acc = MFMA32(*(const bf16x8*)(ap + kk * 16), *(const bf16x8*)(bp + kk * 16), acc);
          const float bias = p.in[14][r]; float* dtb = (float*)(p.ws + WS_DT);
#pragma unroll
          for (int i = 0; i < 16; ++i) { const float v = acc[i] + bias; dtb[(size_t)(T * 32 + crow(i, hh)) * 32 + r] = v > 20.f ? v : log1pf(__expf(v)); }
      } }
    const bf16_t* proj = (const bf16_t*)(p.ws + WS_PROJ);
    bf16_t* bcb = (bf16_t*)(p.ws + WS_PART3);
    const float* convw = p.in[12]; const float* convb = p.in[13];
    for (int task = bid * 512 + tid; task < 1024 * 512; task += G * 512) {
        const int cp = task & 511, sg = task >> 9; const int ch = 2048 + 2 * cp; const int R = sg * 16, pos = R & 2047;
        const bf16_t* src = proj + (size_t)R * PC + C_XBC + ch;
        unsigned raw[19];
#pragma unroll
        for (int i = 0; i < 19; ++i) raw[i] = (pos + i - 3 >= 0) ? __builtin_nontemporal_load((const unsigned*)(src + (ptrdiff_t)(i - 3) * PC)) : 0u;
        float w0[4], w1[4];
#pragma unroll
        for (int k = 0; k < 4; ++k) { w0[k] = convw[k * 3072 + ch]; w1[k] = convw[k * 3072 + ch + 1]; }
        const float b0 = convb[ch], b1 = convb[ch + 1];
#pragma unroll
        for (int i = 0; i < 16; ++i) { float o0 = b0, o1 = b1;
#pragma unroll
            for (int k = 0; k < 4; ++k) { o0 += w0[k] * __uint_as_float(raw[i + k] << 16); o1 += w1[k] * __uint_as_float(raw[i + k] & 0xffff0000u); }
            *(unsigned*)(bcb + (size_t)(R + i) * 1024 + 2 * cp) = pack_bf2(silu_f(o0), silu_f(o1)); }
    }
    for (int task = bid * 512 + tid; task < 128 * 512; task += G * 512) {
        const int cp = task & 511, bs = task >> 9; const int ch = 2048 + 2 * cp; const int R = NPROMPT + bs * 8;
        float e0[11], e1[11];
#pragma unroll
        for (int j = 0; j < 3; ++j) { const f32x2 sv = *(const f32x2*)(p.in[4] + ((size_t)bs * 3 + j) * 3072 + ch); e0[j] = sv[0]; e1[j] = sv[1]; }
#pragma unroll
        for (int k = 0; k < 8; ++k) { const unsigned v = *(const unsigned*)(proj + (size_t)(R + k) * PC + C_XBC + ch); e0[3 + k] = __uint_as_float(v << 16); e1[3 + k] = __uint_as_float(v & 0xffff0000u); }
        float w0[4], w1[4];
#pragma unroll
        for (int k = 0; k < 4; ++k) { w0[k] = convw[k * 3072 + ch]; w1[k] = convw[k * 3072 + ch + 1]; }
        const float b0 = convb[ch], b1 = convb[ch + 1];
#pragma unroll
        for (int i = 0; i < 8; ++i) { float o0 = b0, o1 = b1;
#pragma unroll
            for (int k = 0; k < 4; ++k) { o0 += w0[k] * e0[i + k]; o1 += w1[k] * e1[i + k]; }
            *(unsigned*)(bcb + (size_t)(R + i) * 1024 + 2 * cp) = pack_bf2(silu_f(o0), silu_f(o1)); }
    }
}

DI void ssd_sample_item(const Params& p, unsigned char* lds, int item, const int wid_s, const bool dry = false) {
    const int tid = tid_opaque(wid_s), wid = tid >> 6, lane = tid & 63;
    const int pair = item * 8 + wid, b = pair >> 5, head = pair & 31, g = head >> 3;
    bf16_t* proj = (bf16_t*)(p.ws + WS_PROJ);
    const float* dtbuf = (const float*)(p.ws + WS_DT);
    const float Ah = -__expf(p.in[15][head]);
    const float Dh = p.in[16][head];
    const float* convw = p.in[12]; const float* convb = p.in[13];
    const int R0 = NPROMPT + b * 8;
    float* L = (float*)(lds + wid * 12800);
    float* xw = L;
    float* Bv = xw + 512;
    float* Cv = Bv + 1024;
    float* Mm = Cv + 1024;
    float* Yo = Mm + 64;
    float* sc = Yo + 512;
    float dtk[8], acs[8], eq[8], wv[8];
    { float s = 0.f;
#pragma unroll
        for (int k = 0; k < 8; ++k) { dtk[k] = dtbuf[(size_t)(R0 + k) * 32 + head]; s += dtk[k] * Ah; acs[k] = s; }
#pragma unroll
        for (int k = 0; k < 8; ++k) { eq[k] = __expf(acs[k]); wv[k] = dtk[k] * __expf(acs[7] - acs[k]); } }
    const float cd = __expf(acs[7]);
    if (lane < 8) { sc[lane] = acs[0]; }
#pragma unroll
    for (int k = 0; k < 8; ++k) if (lane == k) { sc[k] = acs[k]; sc[8 + k] = dtk[k]; }
    float xs[8];
    const float* sconv = p.in[4] + (size_t)b * 3 * 3072;
    { const int ch = head * 64 + lane;
        float e[11];
#pragma unroll
        for (int j = 0; j < 3; ++j) e[j] = sconv[j * 3072 + ch];
#pragma unroll
        for (int k = 0; k < 8; ++k) e[3 + k] = bf2f(proj[(size_t)(R0 + k) * PC + C_XBC + ch]);
        const float w0 = convw[ch], w1 = convw[3072 + ch], w2 = convw[2 * 3072 + ch], w3 = convw[3 * 3072 + ch], bb = convb[ch];
#pragma unroll
        for (int k = 0; k < 8; ++k) { const float o = silu_f(bb + w0 * e[k] + w1 * e[k + 1] + w2 * e[k + 2] + w3 * e[k + 3]); xs[k] = o; xw[lane * 8 + k] = o * wv[k]; }
        const bf16_t* bcb = (const bf16_t*)(p.ws + WS_PART3) + (size_t)R0 * 1024 + g * 128;
#pragma unroll
        for (int k = 0; k < 8; ++k) { const unsigned vb = *(const unsigned*)(bcb + (size_t)k * 1024 + 2 * lane), vc = *(const unsigned*)(bcb + (size_t)k * 1024 + 512 + 2 * lane);
            *(f32x2*)(Bv + k * 128 + 2 * lane) = (f32x2){__uint_as_float(vb << 16), __uint_as_float(vb & 0xffff0000u)};
            *(f32x2*)(Cv + k * 128 + 2 * lane) = (f32x2){__uint_as_float(vc << 16), __uint_as_float(vc & 0xffff0000u)}; }
    }
    lds_barrier();
    { const int q = lane >> 3, k = lane & 7; float gsum = 0.f;
        if (k <= q) {
            for (int n = 0; n < 128; n += 4) { const f32x4 cv = *(const f32x4*)(Cv + q * 128 + n); const f32x4 bv = *(const f32x4*)(Bv + k * 128 + n);
                gsum += cv[0] * bv[0] + cv[1] * bv[1] + cv[2] * bv[2] + cv[3] * bv[3]; }
            gsum *= __expf(sc[q] - sc[k]) * sc[8 + k];
        }
        Mm[lane] = gsum; }
    lds_barrier();
    float yd[8];
#pragma unroll
    for (int q = 0; q < 8; ++q) { float s = 0.f;
#pragma unroll
        for (int k = 0; k < 8; ++k) s += Mm[q * 8 + k] * xs[k];
        yd[q] = s; }
    const int half = lane >> 5, nl = lane & 31;
    f32x4 Bq[8], Cq[8];
#pragma unroll
    for (int k = 0; k < 8; ++k) { Bq[k] = *(const f32x4*)(Bv + k * 128 + 4 * nl); Cq[k] = *(const f32x4*)(Cv + k * 128 + 4 * nl); }
    const float* h0 = p.in[5] + (size_t)pair * 8192;
    float* hn = p.out + O_SSMS + (size_t)pair * 8192;
    for (int i0 = 0; i0 < 32; i0 += 8) {
        f32x4 hv[8];
#pragma unroll
        for (int u = 0; u < 8; ++u) hv[u] = __builtin_nontemporal_load((const f32x4*)(h0 + (2 * (i0 + u) + half) * 128 + 4 * nl));
#pragma unroll
        for (int u = 0; u < 8; ++u) {
            const int pp = 2 * (i0 + u) + half;
            float v[8];
#pragma unroll
            for (int q = 0; q < 8; ++q) v[q] = Cq[q][0] * hv[u][0] + Cq[q][1] * hv[u][1] + Cq[q][2] * hv[u][2] + Cq[q][3] * hv[u][3];
            float v4[4], v2[2], v1;
            const bool b4 = (nl & 16) != 0, b3 = (nl & 8) != 0, b2 = (nl & 4) != 0;
#pragma unroll
            for (int j = 0; j < 4; ++j) { const float send = b4 ? v[j] : v[j + 4], keep = b4 ? v[j + 4] : v[j]; v4[j] = keep + xchg16(send, b4); }
#pragma unroll
            for (int j = 0; j < 2; ++j) { const float send = b3 ? v4[j] : v4[j + 2], keep = b3 ? v4[j + 2] : v4[j]; v2[j] = keep + xchg8(send); }
            { const float send = b2 ? v2[0] : v2[1], keep = b2 ? v2[1] : v2[0]; v1 = keep + xchg_hm(send); }
            v1 = dpp_add_x1(v1); v1 = dpp_add_x2(v1);
            if ((nl & 3) == 0) Yo[pp * 8 + (nl >> 2)] = v1;
            const f32x4 xa = *(const f32x4*)(xw + pp * 8), xb = *(const f32x4*)(xw + pp * 8 + 4);
            f32x4 hnew = hv[u] * cd;
            hnew += Bq[0] * xa[0]; hnew += Bq[1] * xa[1]; hnew += Bq[2] * xa[2]; hnew += Bq[3] * xa[3];
            hnew += Bq[4] * xb[0]; hnew += Bq[5] * xb[1]; hnew += Bq[6] * xb[2]; hnew += Bq[7] * xb[3];
            if (!dry) __builtin_nontemporal_store(hnew, (f32x4*)(hn + pp * 128 + 4 * nl));
        }
    }
    lds_barrier();
#pragma unroll
    for (int q = 0; q < 8; ++q) {
        const float y = eq[q] * Yo[lane * 8 + q] + yd[q] + Dh * xs[q];
        const size_t addr = (size_t)(R0 + q) * PC + C_SZ + head * 64 + lane;
        if (!dry) proj[addr] = f2bf(y * bf2f(proj[addr]));
    }
}

DI void attn_prompt_item(const Params& p, unsigned char* lds, int item, const int wid_s, const bool dry = false) {
    const int tid = tid_opaque(wid_s), wid = tid >> 6, lane = tid & 63, r = lane & 31, hh = lane >> 5;
    const int b = item >> 5, h = (item >> 3) & 3, qt = item & 7;
    bf16_t* proj = (bf16_t*)(p.ws + WS_PROJ);
    const int R0 = b * 2048 + qt * 256 + wid * 32;
    bf16_t* Ks = (bf16_t*)lds;
    bf16_t* VT = Ks + 256 * 72;
    const float* Kg = p.out + O_MK + (size_t)(b * 256) * 1024 + h * 256;
    const float* Vg = p.out + O_MV + (size_t)(b * 256) * 1024 + h * 256;
    f32x16 sacc[8];
#pragma unroll
    for (int kt = 0; kt < 8; ++kt) for (int i = 0; i < 16; ++i) sacc[kt][i] = 0.f;
    const bf16_t* qrow = proj + (size_t)(R0 + r) * PC + C_Q + h * 256 + 8 * hh;
    const int skey = tid >> 1, sd0 = (tid & 1) * 32;
    f32x4 stg[8];
#pragma unroll
    for (int j = 0; j < 8; ++j) stg[j] = *(const f32x4*)(Kg + (size_t)skey * 1024 + sd0 + 4 * j);
    for (int dc = 0; dc < 4; ++dc) {
        bf16x8 bq[4];
#pragma unroll
        for (int kk = 0; kk < 4; ++kk) bq[kk] = *(const bf16x8*)(qrow + dc * 64 + kk * 16);
#pragma unroll
        for (int j = 0; j < 4; ++j) { const f32x4 a = stg[2 * j], c4 = stg[2 * j + 1];
            u32x4 w; w.x = pack_bf2(a[0], a[1]); w.y = pack_bf2(a[2], a[3]); w.z = pack_bf2(c4[0], c4[1]); w.w = pack_bf2(c4[2], c4[3]);
            *(u32x4*)(Ks + skey * 72 + sd0 + 8 * j) = w; }
        lds_barrier();
        if (dc < 3) {
#pragma unroll
            for (int j = 0; j < 8; ++j) stg[j] = *(const f32x4*)(Kg + (size_t)skey * 1024 + (dc + 1) * 64 + sd0 + 4 * j); }
#pragma unroll
        for (int kt = 0; kt < 8; ++kt)
#pragma unroll
            for (int kk = 0; kk < 4; ++kk) { const bf16x8 a = *(const bf16x8*)(Ks + (kt * 32 + r) * 72 + kk * 16 + 8 * hh); sacc[kt] = MFMA32(a, bq[kk], sacc[kt]); }
        lds_barrier();
    }
    const int vdg = tid & 15, vkb = tid >> 4;
#pragma unroll
    for (int it = 0; it < 8; ++it) stg[it] = *(const f32x4*)(Vg + (size_t)(vkb + 32 * it) * 1024 + 4 * vdg);
    float m = -3.0e38f;
#pragma unroll
    for (int kt = 0; kt < 8; ++kt)
#pragma unroll
        for (int i = 0; i < 16; ++i) m = fmaxf(m, sacc[kt][i]);
    m = fmaxf(m, __shfl_xor(m, 32));
    float l = 0.f;
#pragma unroll
    for (int kt = 0; kt < 8; ++kt)
#pragma unroll
        for (int i = 0; i < 16; ++i) { const float e = __expf(sacc[kt][i] - m); sacc[kt][i] = e; l += e; }
    l += __shfl_xor(l, 32);
    const float inv = 1.0f / l;
    bf16x8 pk[8][2];
#pragma unroll
    for (int kt = 0; kt < 8; ++kt)
#pragma unroll
        for (int s = 0; s < 2; ++s) { u32x4 w; w.x = pack_bf2(sacc[kt][8 * s], sacc[kt][8 * s + 1]); w.y = pack_bf2(sacc[kt][8 * s + 2], sacc[kt][8 * s + 3]);
            w.z = pack_bf2(sacc[kt][8 * s + 4], sacc[kt][8 * s + 5]); w.w = pack_bf2(sacc[kt][8 * s + 6], sacc[kt][8 * s + 7]); pk[kt][s] = __builtin_bit_cast(bf16x8, w); }
    for (int dc = 0; dc < 4; ++dc) {
#pragma unroll
        for (int it = 0; it < 8; ++it) { const int key = vkb + 32 * it;
#pragma unroll
            for (int j = 0; j < 4; ++j) VT[(4 * vdg + j) * 260 + key] = f2bf(stg[it][j]); }
        lds_barrier();
        if (dc < 3) {
#pragma unroll
            for (int it = 0; it < 8; ++it) stg[it] = *(const f32x4*)(Vg + (size_t)(vkb + 32 * it) * 1024 + (dc + 1) * 64 + 4 * vdg); }
        u32x2 zv[8];
#pragma unroll
        for (int d2 = 0; d2 < 2; ++d2)
#pragma unroll
            for (int gq = 0; gq < 4; ++gq) zv[d2 * 4 + gq] = *(const u32x2*)(proj + (size_t)(R0 + r) * PC + h * 256 + dc * 64 + d2 * 32 + 8 * gq + 4 * hh + C_AZ);
        f32x16 oacc[2];
#pragma unroll
        for (int d2 = 0; d2 < 2; ++d2) for (int i = 0; i < 16; ++i) oacc[d2][i] = 0.f;
#pragma unroll
        for (int kt = 0; kt < 8; ++kt)
#pragma unroll
            for (int s2 = 0; s2 < 2; ++s2)
#pragma unroll
                for (int d2 = 0; d2 < 2; ++d2) { const bf16_t* vr = VT + (d2 * 32 + r) * 260 + kt * 32 + 16 * s2 + 4 * hh;
                    const u32x2 lo = *(const u32x2*)vr, hi = *(const u32x2*)(vr + 8); u32x4 w; w.x = lo.x; w.y = lo.y; w.z = hi.x; w.w = hi.y;
                    oacc[d2] = MFMA32(__builtin_bit_cast(bf16x8, w), pk[kt][s2], oacc[d2]); }
#pragma unroll
        for (int d2 = 0; d2 < 2; ++d2)
#pragma unroll
            for (int gq = 0; gq < 4; ++gq) { const int d = dc * 64 + d2 * 32 + 8 * gq + 4 * hh;
                const size_t rowb = (size_t)(R0 + r) * PC + h * 256 + d;
                const u32x2 z = zv[d2 * 4 + gq];
                u32x2 o; o.x = pack_bf2(oacc[d2][4 * gq] * inv * __uint_as_float(z.x << 16), oacc[d2][4 * gq + 1] * inv * __uint_as_float(z.x & 0xffff0000u));
                o.y = pack_bf2(oacc[d2][4 * gq + 2] * inv * __uint_as_float(z.y << 16), oacc[d2][4 * gq + 3] * inv * __uint_as_float(z.y & 0xffff0000u));
                if (!dry) *(u32x2*)(proj + rowb + C_Q) = o; }
        lds_barrier();
    }
}

DI void attn_sample_item(const Params& p, unsigned char* lds, int item, const int wid_s, const bool dry = false) {
    const int tid = tid_opaque(wid_s), wid = tid >> 6, lane = tid & 63;
    const int b = item >> 2, h = item & 3;
    bf16_t* proj = (bf16_t*)(p.ws + WS_PROJ);
    const int R0 = NPROMPT + b * 8;
    float* S = (float*)lds;
    float* P = S + 2048;
    float* red = P + 2048;
    const float* Kg = p.in[6] + ((size_t)(b * 256) * 4 + h) * 256;
    const float* Vg = p.in[7] + ((size_t)(b * 256) * 4 + h) * 256;
    f32x4 q4[8];
#pragma unroll
    for (int q = 0; q < 8; ++q) { const u32x2 w = *(const u32x2*)(proj + (size_t)(R0 + q) * PC + C_Q + h * 256 + 4 * lane);
        q4[q] = (f32x4){__uint_as_float(w.x << 16), __uint_as_float(w.x & 0xffff0000u), __uint_as_float(w.y << 16), __uint_as_float(w.y & 0xffff0000u)}; }
    const bool b5 = (lane & 32) != 0, b4 = (lane & 16) != 0, b3 = (lane & 8) != 0;
    for (int k0 = 0; k0 < 32; k0 += 16) {
        f32x4 kv[16];
#pragma unroll
        for (int u = 0; u < 16; ++u) kv[u] = __builtin_nontemporal_load((const f32x4*)(Kg + (size_t)(wid * 32 + k0 + u) * 1024 + 4 * lane));
#pragma unroll
        for (int u = 0; u < 16; ++u) {
            float v[8];
#pragma unroll
            for (int q = 0; q < 8; ++q) v[q] = q4[q][0] * kv[u][0] + q4[q][1] * kv[u][1] + q4[q][2] * kv[u][2] + q4[q][3] * kv[u][3];
            float v4[4], v2[2], v1;
#pragma unroll
            for (int j = 0; j < 4; ++j) { const float send = b5 ? v[j] : v[j + 4], keep = b5 ? v[j + 4] : v[j]; v4[j] = keep + xchg32(send, b5); }
#pragma unroll
            for (int j = 0; j < 2; ++j) { const float send = b4 ? v4[j] : v4[j + 2], keep = b4 ? v4[j + 2] : v4[j]; v2[j] = keep + xchg16(send, b4); }
            { const float send = b3 ? v2[0] : v2[1], keep = b3 ? v2[1] : v2[0]; v1 = keep + xchg8(send); }
            v1 = dpp_add_x1(v1); v1 = dpp_add_x2(v1); v1 = dpp_add_hm(v1);
            if ((lane & 7) == 0) S[(lane >> 3) * 256 + wid * 32 + k0 + u] = v1;
        }
    }
    lds_barrier();
    { const f32x4 s4 = *(const f32x4*)(S + wid * 256 + 4 * lane);
        float m = fmaxf(fmaxf(s4[0], s4[1]), fmaxf(s4[2], s4[3]));
#pragma unroll
        for (int o = 32; o > 0; o >>= 1) m = fmaxf(m, __shfl_xor(m, o));
        f32x4 e; float l = 0.f;
#pragma unroll
        for (int j = 0; j < 4; ++j) { e[j] = __expf(s4[j] - m); l += e[j]; }
#pragma unroll
        for (int o = 32; o > 0; o >>= 1) l += __shfl_xor(l, o);
        const float inv = 1.0f / l;
#pragma unroll
        for (int j = 0; j < 4; ++j) P[(4 * lane + j) * 8 + wid] = e[j] * inv; }
    lds_barrier();
    f32x4 oa[8];
#pragma unroll
    for (int q = 0; q < 8; ++q) oa[q] = (f32x4){0.f, 0.f, 0.f, 0.f};
    for (int k0 = 0; k0 < 32; k0 += 16) {
        f32x4 vv[16];
#pragma unroll
        for (int u = 0; u < 16; ++u) vv[u] = __builtin_nontemporal_load((const f32x4*)(Vg + (size_t)(wid * 32 + k0 + u) * 1024 + 4 * lane));
#pragma unroll
        for (int u = 0; u < 16; ++u) { const int key = wid * 32 + k0 + u; const f32x4 pa = *(const f32x4*)(P + key * 8), pb = *(const f32x4*)(P + key * 8 + 4);
            oa[0] += vv[u] * pa[0]; oa[1] += vv[u] * pa[1]; oa[2] += vv[u] * pa[2]; oa[3] += vv[u] * pa[3];
            oa[4] += vv[u] * pb[0]; oa[5] += vv[u] * pb[1]; oa[6] += vv[u] * pb[2]; oa[7] += vv[u] * pb[3]; }
    }
#pragma unroll
    for (int q = 0; q < 8; ++q) *(f32x4*)(red + (wid * 8 + q) * 256 + 4 * lane) = oa[q];
    lds_barrier();
    { const int q = tid >> 6, d = 4 * (tid & 63); f32x4 s = {0.f, 0.f, 0.f, 0.f};
#pragma unroll
        for (int w = 0; w < 8; ++w) s += *(const f32x4*)(red + (w * 8 + q) * 256 + d);
        const size_t rowb = (size_t)(R0 + q) * PC + h * 256 + d;
        const u32x2 z = *(const u32x2*)(proj + rowb + C_AZ);
        u32x2 o; o.x = pack_bf2(s[0] * __uint_as_float(z.x << 16), s[1] * __uint_as_float(z.x & 0xffff0000u));
        o.y = pack_bf2(s[2] * __uint_as_float(z.y << 16), s[3] * __uint_as_float(z.y & 0xffff0000u));
        if (!dry) *(u32x2*)(proj + rowb + C_Q) = o; }
}

template <int W>
DI void pool_fill_prompt(const bf16_t* proj, bf16_t* As, int R0, int c0, int tid) {
    const int cp = tid & 127, seg = tid >> 7;
    const int col = c0 + 2 * cp, rbase = R0 + seg * 32, pos0 = rbase & 2047;
    unsigned raw[32 + W - 1];
#pragma unroll
    for (int i = 0; i < 32 + W - 1; ++i) { const int o = i - (W - 1); raw[i] = (pos0 + o >= 0) ? *(const unsigned*)(proj + (size_t)(rbase + o) * PC + col) : 0u; }
    float s0 = 0.f, s1 = 0.f;
#pragma unroll
    for (int i = 0; i < W - 1; ++i) { s0 += __uint_as_float(raw[i] << 16); s1 += __uint_as_float(raw[i] & 0xffff0000u); }
#pragma unroll
    for (int i = 0; i < 32; ++i) {
        const unsigned cur = raw[i + W - 1]; const float u0 = __uint_as_float(cur << 16), u1 = __uint_as_float(cur & 0xffff0000u);
        s0 += u0; s1 += u1;
        const int pos = pos0 + i; const float inv = 1.0f / (float)((pos + 1) < W ? (pos + 1) : W);
        *(unsigned*)(As + (seg * 32 + i) * 264 + 2 * cp) = pack_bf2(s0 * inv - u0, s1 * inv - u1);
        s0 -= __uint_as_float(raw[i] << 16); s1 -= __uint_as_float(raw[i] & 0xffff0000u);
    }
}
template <int W>
DI void pool_fill_sample(const Params& p, const bf16_t* proj, bf16_t* As, int R0, int c0, int tid) {
    for (int task = tid; task < 2048; task += 512) {
        const int cp = task & 127, bl = task >> 7; const int col = c0 + 2 * cp, row0 = R0 + bl * 8, bs = (row0 - NPROMPT) >> 3;
        float e0[W + 7], e1[W + 7];
#pragma unroll
        for (int i = 0; i < W - 1; ++i) { const f32x2 sv = *(const f32x2*)(p.in[3] + ((size_t)bs * 15 + 15 - (W - 1) + i) * 1024 + col); e0[i] = sv[0]; e1[i] = sv[1]; }
#pragma unroll
        for (int k = 0; k < 8; ++k) { const unsigned v = *(const unsigned*)(proj + (size_t)(row0 + k) * PC + col); e0[W - 1 + k] = __uint_as_float(v << 16); e1[W - 1 + k] = __uint_as_float(v & 0xffff0000u); }
#pragma unroll
        for (int tl = 0; tl < 8; ++tl) { float s0 = 0.f, s1 = 0.f;
#pragma unroll
            for (int j = 0; j < W; ++j) { s0 += e0[W - 1 + tl - j]; s1 += e1[W - 1 + tl - j]; }
            *(unsigned*)(As + (bl * 8 + tl) * 264 + 2 * cp) = pack_bf2(s0 * (1.0f / W) - e0[W - 1 + tl], s1 * (1.0f / W) - e1[W - 1 + tl]); }
    }
}
DI void pool_item(const Params& p, unsigned char* lds, int item, const int wid_s, const bool dry = false) {
    const int tid = tid_opaque(wid_s), wid = tid >> 6, lane = tid & 63, r = lane & 31, hh = lane >> 5;
    const int rt = item >> 2, g = item & 3;
    bf16_t* proj = (bf16_t*)(p.ws + WS_PROJ);
    bf16_t* As = (bf16_t*)lds;
    const int R0 = rt * 128, c0 = g * 256;
    const bf16_t* wpg = (const bf16_t*)(p.ws + WS_WPG) + (size_t)g * 65536;
    bf16x8 bfrag[16];
#pragma unroll
    for (int kk = 0; kk < 16; ++kk) bfrag[kk] = *(const bf16x8*)(wpg + (size_t)(wid * 32 + r) * 256 + kk * 16 + 8 * hh);
    if (R0 < NPROMPT) {
        if (g == 0) pool_fill_prompt<2>(proj, As, R0, c0, tid); else if (g == 1) pool_fill_prompt<4>(proj, As, R0, c0, tid);
        else if (g == 2) pool_fill_prompt<8>(proj, As, R0, c0, tid); else pool_fill_prompt<16>(proj, As, R0, c0, tid);
    } else {
        if (g == 0) pool_fill_sample<2>(p, proj, As, R0, c0, tid); else if (g == 1) pool_fill_sample<4>(p, proj, As, R0, c0, tid);
        else if (g == 2) pool_fill_sample<8>(p, proj, As, R0, c0, tid); else pool_fill_sample<16>(p, proj, As, R0, c0, tid);
    }
    lds_barrier();
    f32x16 acc[4];
#pragma unroll
    for (int t = 0; t < 4; ++t) for (int i = 0; i < 16; ++i) acc[t][i] = 0.f;
#pragma unroll
    for (int t = 0; t < 4; ++t)
#pragma unroll
        for (int kk = 0; kk < 16; ++kk) { const bf16x8 bd = *(const bf16x8*)(As + (t * 32 + r) * 264 + kk * 16 + 8 * hh); acc[t] = MFMA32(bfrag[kk], bd, acc[t]); }
#pragma unroll
    for (int t = 0; t < 4; ++t) {
        u32x2 zv[4];
#pragma unroll
        for (int gq = 0; gq < 4; ++gq) zv[gq] = *(const u32x2*)(proj + (size_t)(R0 + t * 32 + r) * PC + C_PZ + c0 + wid * 32 + 8 * gq + 4 * hh);
#pragma unroll
        for (int gq = 0; gq < 4; ++gq) { const int ch = c0 + wid * 32 + 8 * gq + 4 * hh; const f32x4 scl = *(const f32x4*)(p.in[11] + ch);
            u32x2 o; o.x = pack_bf2(acc[t][4 * gq] * scl[0] * __uint_as_float(zv[gq].x << 16), acc[t][4 * gq + 1] * scl[1] * __uint_as_float(zv[gq].x & 0xffff0000u));
            o.y = pack_bf2(acc[t][4 * gq + 2] * scl[2] * __uint_as_float(zv[gq].y << 16), acc[t][4 * gq + 3] * scl[3] * __uint_as_float(zv[gq].y & 0xffff0000u));
            if (!dry) *(u32x2*)(proj + (size_t)(R0 + t * 32 + r) * PC + C_PZ + ch) = o; }
    }
}

DI void copy_pass(const Params& p, const int wid_s) {
    const int tid = tid_opaque(wid_s), wid = tid >> 6, lane = tid & 63, G = gridDim.x, bid = blockIdx.x;
    const bf16_t* proj = (const bf16_t*)(p.ws + WS_PROJ);
    for (int chunk = bid * 8 + wid; chunk < 3264; chunk += G * 8) {
        float* dst; const bf16_t* sb = nullptr; const float* sf = nullptr;
        if (chunk < 120) { const int b = chunk / 15, j = chunk % 15; dst = p.out + O_POOLP + (size_t)chunk * 1024; sb = proj + (size_t)(b * 2048 + 2033 + j) * PC + C_PU; }
        else if (chunk < 192) { const int q = chunk - 120, row = q / 3, part = q % 3, b = row / 3, j = row % 3; dst = p.out + O_CONVP + (size_t)row * 3072 + part * 1024; sb = proj + (size_t)(b * 2048 + 2045 + j) * PC + C_XBC + part * 1024; }
        else if (chunk < 2112) { const int q = chunk - 192, b = q / 15, j = q % 15; dst = p.out + O_POOLS + (size_t)q * 1024;
            if (j < 7) sf = p.in[3] + ((size_t)b * 15 + 8 + j) * 1024; else sb = proj + (size_t)(NPROMPT + b * 8 + j - 7) * PC + C_PU; }
        else { const int q = chunk - 2112, row = q / 3, part = q % 3, b = row / 3, j = row % 3; dst = p.out + O_CONVS + (size_t)row * 3072 + part * 1024; sb = proj + (size_t)(NPROMPT + b * 8 + 5 + j) * PC + C_XBC + part * 1024; }
#pragma unroll
        for (int hf = 0; hf < 2; ++hf) { const int e = hf * 512 + lane * 8;
            f32x4 lo, hi;
            if (sf) { lo = *(const f32x4*)(sf + e); hi = *(const f32x4*)(sf + e + 4); }
            else { const u32x4 v = *(const u32x4*)(sb + e);
                lo = (f32x4){__uint_as_float(v.x << 16), __uint_as_float(v.x & 0xffff0000u), __uint_as_float(v.y << 16), __uint_as_float(v.y & 0xffff0000u)};
                hi = (f32x4){__uint_as_float(v.z << 16), __uint_as_float(v.z & 0xffff0000u), __uint_as_float(v.w << 16), __uint_as_float(v.w & 0xffff0000u)}; }
            *(f32x4*)(dst + e) = lo; *(f32x4*)(dst + e + 4) = hi; }
    }
}

DI void copy_item(const Params& p, int item, const int wid_s) {
    const bf16_t* proj = (const bf16_t*)(p.ws + WS_PROJ);
    const int tid = tid_opaque(wid_s);
    const int n0 = 8 * 15 * 1024, n1 = 8 * 3 * 3072, n2 = 128 * 15 * 1024, n3 = 128 * 3 * 3072, total = n0 + n1 + n2 + n3;
    for (int i = item * 512 + tid; i < total; i += 64 * 512) {
        int e = i;
        if (e < n0) { const int b = e / 15360, j = (e / 1024) % 15, c = e & 1023; p.out[O_POOLP + e] = bf2f(proj[(size_t)(b * 2048 + 2033 + j) * PC + C_PU + c]); continue; }
        e -= n0;
        if (e < n1) { const int b = e / 9216, j = (e / 3072) % 3, c = e % 3072; p.out[O_CONVP + e] = bf2f(proj[(size_t)(b * 2048 + 2045 + j) * PC + C_XBC + c]); continue; }
        e -= n1;
        if (e < n2) { const int b = e / 15360, j = (e / 1024) % 15, c = e & 1023;
            p.out[O_POOLS + e] = j < 7 ? p.in[3][((size_t)b * 15 + 8 + j) * 1024 + c] : bf2f(proj[(size_t)(NPROMPT + b * 8 + j - 7) * PC + C_PU + c]); continue; }
        e -= n2;
        { const int b = e / 9216, j = (e / 3072) % 3, c = e % 3072; p.out[O_CONVS + e] = bf2f(proj[(size_t)(NPROMPT + b * 8 + 5 + j) * PC + C_XBC + c]); }
    }
}

constexpr int N_T0 = 256, N_T1 = 256, N_T2 = 544, N_T3 = 512, N_T4 = 512, N_T5 = 64;
constexpr int P2_TOTAL = N_T0 + N_T1 + N_T2 + N_T3 + N_T4 + N_T5;

__global__ void __launch_bounds__(512, 2) mega(Params p) {
    extern __shared__ __attribute__((aligned(16))) unsigned char shm[];
    cg::grid_group grid = cg::this_grid();
    const int wid_s = __builtin_amdgcn_readfirstlane((int)threadIdx.x >> 6);
    const int G = gridDim.x, bid = blockIdx.x;
    unsigned char* ws = p.ws;
    LAS unsigned char* lds3 = (LAS unsigned char*)shm;
    { volatile LAS unsigned* st = (volatile LAS unsigned*)(lds3 + QSLOT_OFF + 16); if (tid_opaque(wid_s) == 0) { st[0] = 0u; st[1] = 0u; } __syncthreads(); }
    const XcdBarrier xb = xcd_barrier_post((unsigned*)(ws + WS_BAR), (volatile LAS unsigned*)(lds3 + QSLOT_OFF + 16), wid_s);

    phase0(p, shm, wid_s);
#if PROBE == 1
    grid.sync(); phase0(p, shm, wid_s);
#endif
    if (p.out == nullptr) grid.sync();
    xcd_barrier(xb, wid_s);

    { SchedP1 S; S.h = (const char*)(ws + WS_H); S.win = (const char*)(ws + WS_WIN); S.mh = (const char*)(ws + WS_MH); S.wkv = (const char*)(ws + WS_WKV); S.G = G; S.c = bid;
      EpiP1 E; E.proj = (bf16_t*)(ws + WS_PROJ); E.out = p.out;
      for (int rep = 0; rep < (PROBE == 2 ? 1 + ONE_RT : 1); ++rep) { if (rep) grid.sync(); gemm_phase(lds3, 1024, 1024, 1024, S, E, wid_s); } }
    xcd_barrier(xb, wid_s);

    bc_conv_pass(p, wid_s);
    copy_pass(p, wid_s);
    xcd_barrier(xb, wid_s);

    { int* qslot = (int*)(shm + QSLOT_OFF);
      unsigned* ctr = (unsigned*)(ws + WS_CTR);
#define P2_LOOP(T, N, CALL) for (;;) { __syncthreads(); if (tid_opaque(wid_s) == 0) *qslot = (int)atomicAdd(ctr + (T), 1u); __syncthreads(); const int item = *qslot; if (item >= (N)) break; CALL; }
      for (int pass = 0; pass < (PROBE == 3 ? 1 + ONE_RT : 1); ++pass) { __syncthreads(); if (tid_opaque(wid_s) == 0) qslot[1] = pass ? PROBE_LVL : 0; P2_LOOP(0 + 8 * pass, N_T0, ssd_prompt_item(p, shm, item, wid_s)) }
      for (int pass = 0; pass < ((PROBE == 4 || PROBE == 7) ? 1 + ONE_RT : 1); ++pass) P2_LOOP(1 + 8 * pass, N_T1, attn_prompt_item(p, shm, item, wid_s, pass > 0))
      for (int pass = 0; pass < ((PROBE == 4 || PROBE == 8) ? 1 + ONE_RT : 1); ++pass) P2_LOOP(2 + 8 * pass, N_T2, pool_item(p, shm, item, wid_s, pass > 0))
      for (int pass = 0; pass < ((PROBE == 5 || PROBE == 9) ? 1 + ONE_RT : 1); ++pass) P2_LOOP(3 + 8 * pass, N_T3, ssd_sample_item(p, shm, item, wid_s, pass > 0))
      for (int pass = 0; pass < ((PROBE == 5 || PROBE == 10) ? 1 + ONE_RT : 1); ++pass) P2_LOOP(4 + 8 * pass, N_T4, attn_sample_item(p, shm, item, wid_s, pass > 0))
#undef P2_LOOP
    }
    xcd_barrier(xb, wid_s);

    { const int tid = tid_opaque(wid_s), wid = tid >> 6, lane = tid & 63; float* rstd = (float*)(ws + WS_SSQ);
#pragma unroll 2
      for (int row = bid * 8 + wid; row < NTOK; row += G * 8) { const bf16_t* yr = (const bf16_t*)(ws + WS_PROJ) + (size_t)row * PC + C_SZ + lane * 8; float t = 0.f;
#pragma unroll
          for (int j = 0; j < 4; ++j) { const u32x4 v = *(const u32x4*)(yr + j * 512);
#pragma unroll
              for (int e = 0; e < 4; ++e) { const float a = __uint_as_float(v[e] << 16), c2 = __uint_as_float(v[e] & 0xffff0000u); t += a * a + c2 * c2; } }
#pragma unroll
          for (int o = 32; o > 0; o >>= 1) t += __shfl_xor(t, o);
          if (lane == 0) rstd[row] = rsqrtf(t * (1.0f / 2048.0f) + EPS); } }
    { SchedP3 S; S.proj = (const char*)(ws + WS_PROJ); S.wcat = (const char*)(ws + WS_WCAT); S.G = G; S.c = bid;
      EpiP3 E; E.part[0] = (bf16_t*)(ws + WS_H); E.part[1] = (bf16_t*)p.out; E.part[2] = (bf16_t*)p.out + (size_t)NTOK * 1024; E.part[3] = (bf16_t*)(ws + WS_PART3);
      for (int rep = 0; rep < (PROBE == 6 ? 1 + ONE_RT : 1); ++rep) { if (rep) grid.sync(); gemm_phase(lds3, 1024, PC, 4096, S, E, wid_s); } }
    xcd_barrier(xb, wid_s);

    { const int tid = tid_opaque(wid_s);
      bf16_t* p0 = (bf16_t*)(ws + WS_H); const bf16_t* p1 = (const bf16_t*)p.out; const bf16_t* p2 = p1 + (size_t)NTOK * 1024; const bf16_t* p3 = (const bf16_t*)(ws + WS_PART3);
      const bf16_t* proj = (const bf16_t*)(ws + WS_PROJ); const float* ssq = (const float*)(ws + WS_SSQ);
      const size_t n8 = (size_t)NTOK * 128;
#pragma unroll 2
      for (size_t i = (size_t)bid * 512 + tid; i < n8; i += (size_t)G * 512) {
          const size_t row = i >> 7; const int c8 = (int)(i & 127) * 8;
          const float rs = ssq[row];
          const u32x4 a0 = __builtin_nontemporal_load((const u32x4*)(p0 + i * 8)), a1 = __builtin_nontemporal_load((const u32x4*)(p1 + i * 8)), a2 = __builtin_nontemporal_load((const u32x4*)(p2 + i * 8)), a3 = __builtin_nontemporal_load((const u32x4*)(p3 + i * 8));
          const bf16_t* gp = proj + row * PC + C_G + c8;
          const u32x4 g0 = __builtin_nontemporal_load((const u32x4*)gp), g1 = __builtin_nontemporal_load((const u32x4*)(gp + 1024)), g2 = __builtin_nontemporal_load((const u32x4*)(gp + 2048));
          u32x4 o;
#pragma unroll
          for (int j = 0; j < 4; ++j) {
              const float lo = sigmoid_f(__uint_as_float(g0[j] << 16)) * __uint_as_float(a0[j] << 16) + sigmoid_f(__uint_as_float(g1[j] << 16)) * rs * (__uint_as_float(a1[j] << 16) + __uint_as_float(a2[j] << 16)) + sigmoid_f(__uint_as_float(g2[j] << 16)) * __uint_as_float(a3[j] << 16);
              const float hi = sigmoid_f(__uint_as_float(g0[j] & 0xffff0000u)) * __uint_as_float(a0[j] & 0xffff0000u) + sigmoid_f(__uint_as_float(g1[j] & 0xffff0000u)) * rs * (__uint_as_float(a1[j] & 0xffff0000u) + __uint_as_float(a2[j] & 0xffff0000u)) + sigmoid_f(__uint_as_float(g2[j] & 0xffff0000u)) * __uint_as_float(a3[j] & 0xffff0000u);
              o[j] = pack_bf2(lo, hi); }
          *(u32x4*)(p0 + i * 8) = o; } }
    xcd_barrier(xb, wid_s);

    { EpiP4 E; E.out = p.out; E.xp = p.in[0]; E.xs = p.in[1]; E.partq = (float*)(ws + WS_PART3);
      SchedP4 S; S.mg = (const char*)(ws + WS_H); S.wo = (const char*)(ws + WS_WO); S.G = G; S.c = bid;
      for (int rep = 0; rep < (PROBE == 6 ? 1 + ONE_RT : 1); ++rep) { if (rep) grid.sync(); gemm_phase(lds3, 1024, 1024, 1024, S, E, wid_s); } }
    xcd_barrier(xb, wid_s);

    { const int tid = tid_opaque(wid_s), wid = tid >> 6, lane = tid & 63;
#pragma unroll 2
    for (int row = bid * 8 + wid; row < NTOK; row += G * 8) {
        float* o = p.out + (size_t)row * 1024; const float* w = p.in[25];
        f32x4 v[4]; float ss = 0.f;
#pragma unroll
        for (int j = 0; j < 4; ++j) v[j] = __builtin_nontemporal_load((const f32x4*)(o + j * 256 + lane * 4));
        if (row >= 13312) { const float* pq = (const float*)(ws + WS_PART3) + (size_t)(row - 13312) * 256 + lane * 4;
#pragma unroll
            for (int kq = 0; kq < 3; ++kq) v[3] += *(const f32x4*)(pq + (size_t)kq * 4096 * 256); }
#pragma unroll
        for (int j = 0; j < 4; ++j) ss += v[j][0] * v[j][0] + v[j][1] * v[j][1] + v[j][2] * v[j][2] + v[j][3] * v[j][3];
#pragma unroll
        for (int of = 32; of > 0; of >>= 1) ss += __shfl_xor(ss, of);
        const float rs = rsqrtf(ss * (1.0f / 1024.0f) + EPS);
#pragma unroll
        for (int j = 0; j < 4; ++j) { const f32x4 wv = *(const f32x4*)(w + j * 256 + lane * 4); f32x4 r4 = v[j] * rs; r4 *= wv; __builtin_nontemporal_store(r4, (f32x4*)(o + j * 256 + lane * 4)); }
    } }
}

extern "C" void kernel_launch(void* const* d_in, const int* in_sizes, int n_in, void* d_out, int out_size, void* d_ws, size_t ws_size, hipStream_t stream) {
    static int grid_blocks = 0;
    if (grid_blocks == 0) {
        if (n_in != 26 || ws_size < WS_END) { fprintf(stderr, "kernel_launch: unexpected problem shape (n_in %d, ws %zu < %zu)\n", n_in, ws_size, (size_t)WS_END); grid_blocks = -1; return; }
        int dev = 0, cus = 0, per_cu = 0;
        hipGetDevice(&dev);
        hipDeviceGetAttribute(&cus, hipDeviceAttributeMultiprocessorCount, dev);
        if (hipFuncSetAttribute((const void*)mega, hipFuncAttributeMaxDynamicSharedMemorySize, LDS_BYTES) != hipSuccess) { fprintf(stderr, "kernel_launch: hipFuncSetAttribute failed\n"); grid_blocks = -1; return; }
        if (hipOccupancyMaxActiveBlocksPerMultiprocessor(&per_cu, (const void*)mega, 512, LDS_BYTES) != hipSuccess || per_cu < 1) { fprintf(stderr, "kernel_launch: occupancy query says %d\n", per_cu); per_cu = 1; }
        (void)hipGetLastError();
        grid_blocks = cus;
    }
    if (grid_blocks < 0) return;
    (void)hipMemsetAsync((unsigned char*)d_ws + WS_BAR, 0, 16384, stream);
    Params p{};
    for (int i = 0; i < 26; ++i) p.in[i] = (const float*)d_in[i];
    p.out = (float*)d_out; p.ws = (unsigned char*)d_ws;
    void* args[] = {&p};
    hipError_t e = hipLaunchCooperativeKernel((const void*)mega, dim3(grid_blocks), dim3(512), args, LDS_BYTES, stream);
    if (e != hipSuccess) fprintf(stderr, "cooperative launch failed: %s (grid %d)\n", hipGetErrorString(e), grid_blocks);
}
```

```cpp
#include <hip/hip_runtime.h>
#include <hip/hip_cooperative_groups.h>
#include <cstdio>
namespace cg = cooperative_groups;

#define DI __device__ __forceinline__
#define LAS __attribute__((address_space(3)))
typedef unsigned short bf16_t;
typedef short bf16x8 __attribute__((ext_vector_type(8)));
typedef float f32x2 __attribute__((ext_vector_type(2)));
typedef float f32x4 __attribute__((ext_vector_type(4)));
typedef float f32x16 __attribute__((ext_vector_type(16)));
typedef unsigned u32x2 __attribute__((ext_vector_type(2)));
typedef unsigned u32x4 __attribute__((ext_vector_type(4)));
typedef __bf16 bf16x2v __attribute__((ext_vector_type(2)));

constexpr int NTOK = 17408, NPROMPT = 16384;
constexpr int PC = 12288;
constexpr int C_PU = 0, C_PZ = 1024, C_SZ = 2048, C_XBC = 4096, C_Q = 7168, C_AZ = 8192, C_G = 9216;
constexpr int IN_COLS = 12320;
constexpr float EPS = 1e-6f;

constexpr size_t WS_PROJ = 0;
constexpr size_t WS_H    = WS_PROJ + (size_t)NTOK * PC * 2;
constexpr size_t WS_WIN  = WS_H + (size_t)NTOK * 1024 * 2;
constexpr size_t WS_WKV  = WS_WIN + (size_t)PC * 1024 * 2;
constexpr size_t WS_WCAT = WS_WKV + (size_t)2048 * 1024 * 2;
constexpr size_t WS_WO   = WS_WCAT + (size_t)1024 * 4096 * 2;
constexpr size_t WS_WPG  = WS_WO + (size_t)1024 * 1024 * 2;
constexpr size_t WS_MH   = WS_WPG + (size_t)4 * 256 * 256 * 2;
constexpr size_t WS_DT   = WS_MH + (size_t)2048 * 1024 * 2;
constexpr size_t WS_SSQ  = WS_DT + (size_t)NTOK * 32 * 4;
constexpr size_t WS_CTR  = WS_SSQ + (size_t)NTOK * 4;
constexpr size_t WS_PART3 = WS_CTR + 256;
constexpr size_t WS_SSQP = WS_PART3 + (size_t)NTOK * 1024 * 2;
constexpr size_t WS_BAR  = WS_SSQP + (1u << 20);
constexpr size_t WS_END  = WS_SSQP + (size_t)NTOK * 64 * 4;

constexpr size_t O_YP = 0, O_POOLP = 17825792, O_CONVP = 17948672, O_SSMP = 18022400, O_MK = 20119552, O_MV = 22216704,
                 O_POOLS = 24313856, O_CONVS = 26279936, O_SSMS = 27459584;

constexpr int LDS_BYTES = 147456;
constexpr int QSLOT_OFF = LDS_BYTES - 256;
#define ONE_RT (__builtin_amdgcn_readfirstlane(((volatile unsigned*)(p.ws + WS_CTR))[15] == 0u ? 1 : 0))
#define PROBE 0

struct Params { const float* in[26]; float* out; unsigned char* ws; };

DI float bf2f(bf16_t u) { return __uint_as_float(((unsigned)u) << 16); }
DI unsigned pack_bf2(float lo, float hi) { f32x2 v = {lo, hi}; bf16x2v b = __builtin_convertvector(v, bf16x2v); return __builtin_bit_cast(unsigned, b); }
DI bf16_t f2bf(float x) { return (bf16_t)(pack_bf2(x, 0.f) & 0xffffu); }
DI float silu_f(float x) { return x * __builtin_amdgcn_rcpf(1.f + __expf(-x)); }
DI float sigmoid_f(float x) { return __builtin_amdgcn_rcpf(1.f + __expf(-x)); }
DI int tid_opaque(int wid_s) { int t = wid_s * 64 + (int)__builtin_amdgcn_mbcnt_hi(~0u, __builtin_amdgcn_mbcnt_lo(~0u, 0u)); asm volatile("" : "+v"(t)); return t; }
DI void lds_barrier() { asm volatile("s_waitcnt lgkmcnt(0)" ::: "memory"); __builtin_amdgcn_s_barrier(); asm volatile("" ::: "memory"); }
DI float dpp_add_x1(float v) { return v + __builtin_bit_cast(float, __builtin_amdgcn_update_dpp(0, __builtin_bit_cast(int, v), 0xB1, 0xf, 0xf, false)); }
DI float dpp_add_x2(float v) { return v + __builtin_bit_cast(float, __builtin_amdgcn_update_dpp(0, __builtin_bit_cast(int, v), 0x4E, 0xf, 0xf, false)); }
DI float dpp_add_hm(float v) { return v + __builtin_bit_cast(float, __builtin_amdgcn_update_dpp(0, __builtin_bit_cast(int, v), 0x141, 0xf, 0xf, false)); }
DI float xchg32(float v, bool upper) { const unsigned u = __builtin_bit_cast(unsigned, v); auto r = __builtin_amdgcn_permlane32_swap(u, u, false, false); return __builtin_bit_cast(float, upper ? r[0] : r[1]); }
DI float xchg16(float v, bool odd) { const unsigned u = __builtin_bit_cast(unsigned, v); auto r = __builtin_amdgcn_permlane16_swap(u, u, false, false); return __builtin_bit_cast(float, odd ? r[0] : r[1]); }
DI float xchg8(float v) { return __builtin_bit_cast(float, __builtin_amdgcn_update_dpp(0, __builtin_bit_cast(int, v), 0x128, 0xf, 0xf, false)); }
DI float xchg_hm(float v) { return __builtin_bit_cast(float, __builtin_amdgcn_update_dpp(0, __builtin_bit_cast(int, v), 0x141, 0xf, 0xf, false)); }
DI int crow(int reg, int h) { return (reg & 3) + 8 * (reg >> 2) + 4 * h; }
#define MFMA32(a, b, c) __builtin_amdgcn_mfma_f32_32x32x16_bf16((a), (b), (c), 0, 0, 0)
DI const float* xrow(const Params& p, int row) { return row < NPROMPT ? p.in[0] + (size_t)row * 1024 : p.in[1] + (size_t)(row - NPROMPT) * 1024; }


#define XB_TMO      128
#define XB_XCNT(j)  (256  + 64 * (j))
#define XB_XSUB(j)  (1280 + 64 * (j))
#define XB_XGEN(j)  (2304 + 64 * (j))
#define XB_TOP      3328
#define XB_TOPGEN   3392
#define XCD_BAR_WORDS 3456
#define XB_SPIN_CAP (1u << 18)
DI unsigned xb_ld(unsigned* p)              { return __hip_atomic_load(p, __ATOMIC_RELAXED, __HIP_MEMORY_SCOPE_AGENT); }
DI unsigned xb_add(unsigned* p, unsigned v) { return __hip_atomic_fetch_add(p, v, __ATOMIC_RELAXED, __HIP_MEMORY_SCOPE_AGENT); }
DI unsigned xb_xcc_id() { return (unsigned)__builtin_amdgcn_s_getreg((3 << 11) | 20) & 0xFu; }
#define XB_SPIN(cond, bar) do { unsigned _sp = 0; while (cond) { __builtin_amdgcn_s_sleep(1); \
    if ((++_sp & 255u) == 0u) { if (xb_ld(&(bar)[XB_TMO])) break; if (_sp > XB_SPIN_CAP) { atomicAdd(&(bar)[XB_TMO], 1u); break; } } } } while (0)
struct XcdBarrier { unsigned* bar; unsigned x; volatile LAS unsigned* st; };
DI XcdBarrier xcd_barrier_post(unsigned* bar, volatile LAS unsigned* st, int wid_s) {
    XcdBarrier b; b.bar = bar; b.x = xb_xcc_id(); b.st = st;
    if (tid_opaque(wid_s) == 0) (void)xb_add(&bar[XB_XCNT(b.x)], 1u);
    return b;
}
DI void xcd_barrier_complete(unsigned* bar, unsigned x, unsigned& nloc, unsigned& nx) {
    const unsigned G = gridDim.x * gridDim.y * gridDim.z;
    unsigned sum, cnt, mine, sp = 0u;
    for (;;) {
        sum = 0u; cnt = 0u; mine = 0u;
#pragma unroll
        for (unsigned j = 0; j < 16; ++j) { const unsigned c = xb_ld(&bar[XB_XCNT(j)]); sum += c; cnt += (c > 0u) ? 1u : 0u; mine = (j == x) ? c : mine; }
        if (sum == G) break;
        __builtin_amdgcn_s_sleep(1);
        if ((++sp & 255u) == 0u) { if (xb_ld(&bar[XB_TMO])) break; if (sp > XB_SPIN_CAP) { atomicAdd(&bar[XB_TMO], 1u); break; } }
    }
    nloc = mine > 0u ? mine : 1u; nx = cnt > 0u ? cnt : 1u;
}
DI void xcd_barrier(const XcdBarrier& b, int wid_s) {
    asm volatile("s_waitcnt vmcnt(0)" ::: "memory");
    __syncthreads();
    if (tid_opaque(wid_s) == 0) {
        unsigned* bar = b.bar;
        __builtin_amdgcn_s_waitcnt(0);
        unsigned nloc = b.st[0], nx = b.st[1];
        if (nloc == 0u) { xcd_barrier_complete(bar, b.x, nloc, nx); b.st[0] = nloc; b.st[1] = nx; }
        const unsigned old = xb_add(&bar[XB_XSUB(b.x)], 1u);
        const unsigned gen = old / nloc;
        if (old + 1u == (gen + 1u) * nloc) {
            __builtin_amdgcn_fence(__ATOMIC_RELEASE, "agent");
            asm volatile("s_waitcnt vmcnt(0)" ::: "memory");
            const unsigned og = xb_add(&bar[XB_TOP], 1u);
            const unsigned tg = og / nx;
            if (og + 1u == (tg + 1u) * nx) xb_add(&bar[XB_TOPGEN], 1u);
            else XB_SPIN(xb_ld(&bar[XB_TOPGEN]) == tg, bar);
            __builtin_amdgcn_fence(__ATOMIC_ACQUIRE, "agent");
            xb_add(&bar[XB_XGEN(b.x)], 1u);
            asm volatile("s_waitcnt vmcnt(0)" ::: "memory");
        } else {
            XB_SPIN(xb_ld(&bar[XB_XGEN(b.x)]) == gen, bar);
            __builtin_amdgcn_fence(__ATOMIC_ACQUIRE, "agent");
            asm volatile("s_waitcnt vmcnt(0)" ::: "memory");
        }
    }
    __syncthreads();
}

constexpr int BM = 256, BK = 64, HALF = 128, HTB = HALF * BK * 2;
DI int lds_byte(int r, int c) { const int st = (r >> 4) * 2 + (c >> 5), rr = r & 15, cc = c & 31, ob = rr * 64 + cc * 2; return st * 1024 + (ob ^ (((ob >> 9) & 1) << 5)); }
DI void stage_rc(int b, int& R, int& C) { const int st = b / 1024, sb = b % 1024, swz = sb ^ (((sb >> 9) & 1) << 5); R = (st >> 1) * 16 + swz / 64; C = (st & 1) * 32 + (swz % 64) / 2; }
DI int perm32(int rho) { const int n = rho >> 4, i = rho & 15; return 8 * (i >> 2) + 4 * n + (i & 3); }
struct GUnit { const char* a; const char* b; int pm, pn, aux, nt; };

template <class Sched, class Epi>
DI void gemm_phase(LAS unsigned char* lds, const int K, const int lda, const int ldb, const Sched& S, const Epi& E, const int wid_s) {
    int tid_ = tid_opaque(wid_s);
    const int tid = tid_, wid = __builtin_amdgcn_readfirstlane(tid >> 6), lane = tid & 63, wr = wid >> 2, wc = wid & 3, fr = lane & 15, fq = lane >> 4;
    unsigned voffA[2], voffB[2];
#pragma unroll
    for (int i = 0; i < 2; ++i) { int R, C; stage_rc(tid * 16 + i * 8192, R, C); const int Rb = (R & ~31) + perm32(R & 31);
        voffA[i] = (unsigned)(R * lda + C) * 2u; voffB[i] = (unsigned)(Rb * ldb + C) * 2u; }
    const size_t kstep = (size_t)(BK * 2);
    const size_t hstepA = (size_t)HALF * lda * 2, hstepB = (size_t)HALF * ldb * 2;
    const unsigned ldsw = (unsigned)wid * 1024u;
    const int aoff = lds_byte(wr * 64 + fr, fq * 8), boff = lds_byte(wc * 32 + fr, fq * 8);
#define PG8_SA(b, h) (((b) * 2 + (h)) * HTB)
#define PG8_SB(b, h) ((4 + (b) * 2 + (h)) * HTB)
#define PG8_STAGE(bufoff, gbase, voff) do { _Pragma("unroll") for (int _i = 0; _i < 2; ++_i) \
        __builtin_amdgcn_global_load_lds((const unsigned*)((const char*)(gbase) + (voff)[_i]), (LAS unsigned*)(lds + (bufoff) + ldsw + _i * 8192), 16, 0, 0); } while (0)
#define PG8_LDA(dst, b, h) do { _Pragma("unroll") for (int m = 0; m < 4; ++m) _Pragma("unroll") for (int k = 0; k < 2; ++k) dst[m][k] = *(const LAS bf16x8*)(lds + PG8_SA(b, h) + aoff + m * 2048 + k * 1024); } while (0)
#define PG8_LDB(dst, b, h) do { _Pragma("unroll") for (int n = 0; n < 2; ++n) _Pragma("unroll") for (int k = 0; k < 2; ++k) dst[n][k] = *(const LAS bf16x8*)(lds + PG8_SB(b, h) + boff + n * 2048 + k * 1024); } while (0)
#define PG8_MMA(ai, bj, At, Bt) do { __builtin_amdgcn_s_setprio(1); _Pragma("unroll") for (int m = 0; m < 4; ++m) _Pragma("unroll") for (int n = 0; n < 2; ++n) _Pragma("unroll") for (int k = 0; k < 2; ++k) \
        acc[ai][bj][m][n] = __builtin_amdgcn_mfma_f32_16x16x32_bf16(Bt[n][k], At[m][k], acc[ai][bj][m][n], 0, 0, 0); __builtin_amdgcn_s_setprio(0); } while (0)
#define PG8_WAIT_V(n) asm volatile("s_waitcnt vmcnt(" #n ")" ::: "memory")
#define PG8_WAIT_L(n) asm volatile("s_waitcnt lgkmcnt(" #n ")" ::: "memory")
#define PG8_BAR __builtin_amdgcn_s_barrier()
#define PG8_SCHED __builtin_amdgcn_sched_barrier(0)
    GUnit cur, nxt; int ui = 0;
    if (!S.next(0, cur)) return;
    f32x4 acc[2][2][4][2];
#pragma unroll
    for (int a = 0; a < 2; ++a)
#pragma unroll
        for (int b = 0; b < 2; ++b)
#pragma unroll
            for (int m = 0; m < 4; ++m)
#pragma unroll
                for (int n = 0; n < 2; ++n) acc[a][b][m][n] = (f32x4){0.f, 0.f, 0.f, 0.f};
    bf16x8 At[4][2], B0[2][2], B1[2][2];
    const char* cA = cur.a; const char* cB = cur.b;
    PG8_STAGE(PG8_SB(0, 0), cB, voffB); PG8_STAGE(PG8_SA(0, 0), cA, voffA); PG8_STAGE(PG8_SB(0, 1), cB + hstepB, voffB); PG8_STAGE(PG8_SA(0, 1), cA + hstepA, voffA);
    if (wr == 1) PG8_BAR;
    PG8_WAIT_V(4); PG8_BAR;
    PG8_STAGE(PG8_SB(1, 0), cB + kstep, voffB); PG8_STAGE(PG8_SA(1, 0), cA + kstep, voffA); PG8_STAGE(PG8_SB(1, 1), cB + hstepB + kstep, voffB);
    PG8_WAIT_V(6); PG8_BAR;
    for (;;) {
        const bool has_next = S.next(ui + 1, nxt);
        const char* nA = has_next ? nxt.a : cA; const char* nB = has_next ? nxt.b : cB;
        const int nt = cur.nt;
        for (int t = 0; t < nt; t += 2) {
            const bool last = (t == nt - 2);
            const char* a1 = cA + (size_t)(t + 1) * kstep;
            const char* a2 = last ? nA : cA + (size_t)(t + 2) * kstep; const char* b2 = last ? nB : cB + (size_t)(t + 2) * kstep;
            const char* a3 = a2 + kstep; const char* b3 = b2 + kstep;
            PG8_LDB(B0, 0, 0); PG8_SCHED; PG8_LDA(At, 0, 0); PG8_STAGE(PG8_SA(1, 1), a1 + hstepA, voffA);
            PG8_WAIT_L(8); PG8_BAR; PG8_WAIT_L(0); PG8_MMA(0, 0, At, B0); PG8_BAR; PG8_SCHED;
            PG8_LDB(B1, 0, 1); PG8_STAGE(PG8_SB(0, 0), b2, voffB);
            PG8_BAR; PG8_WAIT_L(0); PG8_MMA(0, 1, At, B1); PG8_BAR;
            PG8_LDA(At, 0, 1); PG8_STAGE(PG8_SA(0, 0), a2, voffA);
            PG8_BAR; PG8_WAIT_L(0); PG8_MMA(1, 0, At, B0); PG8_BAR; PG8_SCHED;
            PG8_STAGE(PG8_SB(0, 1), b2 + hstepB, voffB);
            PG8_WAIT_V(6); PG8_BAR; PG8_MMA(1, 1, At, B1); PG8_BAR;
            PG8_LDB(B0, 1, 0); PG8_SCHED; PG8_LDA(At, 1, 0); PG8_STAGE(PG8_SA(0, 1), a2 + hstepA, voffA);
            PG8_WAIT_L(8); PG8_BAR; PG8_WAIT_L(0); PG8_MMA(0, 0, At, B0); PG8_BAR; PG8_SCHED;
            PG8_LDB(B1, 1, 1); PG8_STAGE(PG8_SB(1, 0), b3, voffB);
            PG8_BAR; PG8_WAIT_L(0); PG8_MMA(0, 1, At, B1); PG8_BAR;
            PG8_LDA(At, 1, 1); PG8_STAGE(PG8_SA(1, 0), a3, voffA);
            PG8_BAR; PG8_WAIT_L(0); PG8_MMA(1, 0, At, B0); PG8_BAR; PG8_SCHED;
            PG8_STAGE(PG8_SB(1, 1), b3 + hstepB, voffB);
            PG8_WAIT_V(6); PG8_BAR; PG8_MMA(1, 1, At, B1); PG8_BAR;
        }
        E(acc, cur, wr, wc, fr, fq);
        if (!has_next) break;
#pragma unroll
        for (int a = 0; a < 2; ++a)
#pragma unroll
            for (int b = 0; b < 2; ++b)
#pragma unroll
                for (int m = 0; m < 4; ++m)
#pragma unroll
                    for (int n = 0; n < 2; ++n) acc[a][b][m][n] = (f32x4){0.f, 0.f, 0.f, 0.f};
        cur = nxt; cA = nA; cB = nB; ++ui;
    }
    PG8_WAIT_V(0);
    if (wr == 0) PG8_BAR;
    PG8_BAR;
#undef PG8_SA
#undef PG8_SB
#undef PG8_STAGE
#undef PG8_LDA
#undef PG8_LDB
#undef PG8_MMA
#undef PG8_WAIT_V
#undef PG8_WAIT_L
#undef PG8_BAR
#undef PG8_SCHED
}

struct SchedP1 {
    const char* h; const char* win; const char* mh; const char* wkv; int G, c;
    DI bool next(int i, GUnit& u) const {
        const int L = i * G + c;
        if (L >= 3328) return false;
        if (L < 3264) {
            const int nM = 68, nN = 48, nwg = 3264; int wgid = L;
            { const int q = nwg / 8, r = nwg % 8, xcd = wgid % 8, off = wgid / 8; wgid = (xcd < r ? xcd * (q + 1) : r * (q + 1) + (xcd - r) * q) + off; }
            const int nig = 8 * nN, gid = wgid / nig, fm = gid * 8, gsz = (nM - fm) < 8 ? (nM - fm) : 8;
            u.pm = fm + ((wgid % nig) % gsz); u.pn = (wgid % nig) / gsz; u.aux = 0; u.nt = 16;
            u.a = h + (size_t)u.pm * 256 * 1024 * 2; u.b = win + (size_t)u.pn * 256 * 1024 * 2;
        } else {
            const int idx = L - 3264; u.pm = idx >> 3; u.pn = idx & 7; u.aux = 1; u.nt = 16;
            u.a = mh + (size_t)u.pm * 256 * 1024 * 2; u.b = wkv + (size_t)u.pn * 256 * 1024 * 2;
        }
        return true;
    }
};
struct SchedP3 {
    const char* proj; const char* wcat; int G, c;
    DI bool next(int i, GUnit& u) const {
        const int L = i * G + c;
        if (L >= 1088) return false;
        const int part = L / 272, tile = L % 272; u.pm = tile % 68; u.pn = tile / 68; u.aux = part; u.nt = 16;
        const int acol = part == 0 ? C_PZ : (part == 1 ? C_SZ : (part == 2 ? C_SZ + 1024 : C_Q));
        u.a = proj + ((size_t)u.pm * 256 * PC + acol) * 2; u.b = wcat + ((size_t)u.pn * 256 * 4096 + part * 1024) * 2;
        return true;
    }
};
struct SchedP4 {
    const char* mg; const char* wo; int G, c;
    DI bool next(int i, GUnit& u) const {
        const int L = i * G + c;
        if (L >= 320) return false;
        if (L < 256) { u.pm = L % 68; u.pn = L / 68; u.aux = 0; u.nt = 16;
            u.a = mg + ((size_t)u.pm * 256 * 1024) * 2; u.b = wo + ((size_t)u.pn * 256 * 1024) * 2; }
        else { const int q = L - 256, tile = 256 + (q >> 2), kq = q & 3; u.pm = tile % 68; u.pn = tile / 68; u.aux = kq; u.nt = 4;
            u.a = mg + ((size_t)u.pm * 256 * 1024 + kq * 256) * 2; u.b = wo + ((size_t)u.pn * 256 * 1024 + kq * 256) * 2; }
        return true;
    }
};

struct EpiP1 {
    bf16_t* proj; float* out;
    DI void operator()(const f32x4 (&acc)[2][2][4][2], const GUnit& u, int wr, int wc, int fr, int fq) const {
        const int row0 = u.pm * 256 + wr * 64 + fr, col0 = u.pn * 256 + wc * 32 + 8 * fq;
        if (u.aux == 0) {
            const int cb = u.pn * 256;
            const int act = (cb >= C_G) ? 0 : (((cb >= C_PZ && cb < C_XBC) || (cb >= C_AZ)) ? 1 : 0);
#pragma unroll
            for (int ai = 0; ai < 2; ++ai)
#pragma unroll
                for (int m = 0; m < 4; ++m) { bf16_t* rowp = proj + (size_t)(row0 + ai * HALF + m * 16) * PC + col0;
#pragma unroll
                    for (int bj = 0; bj < 2; ++bj) { f32x4 v0 = acc[ai][bj][m][0], v1 = acc[ai][bj][m][1];
                        if (act == 1) {
#pragma unroll
                            for (int j = 0; j < 4; ++j) { v0[j] = silu_f(v0[j]); v1[j] = silu_f(v1[j]); } }
                        else if (act == 2) {
#pragma unroll
                            for (int j = 0; j < 4; ++j) { v0[j] = sigmoid_f(v0[j]); v1[j] = sigmoid_f(v1[j]); } }
                        u32x4 w; w.x = pack_bf2(v0[0], v0[1]); w.y = pack_bf2(v0[2], v0[3]); w.z = pack_bf2(v1[0], v1[1]); w.w = pack_bf2(v1[2], v1[3]);
                        __builtin_nontemporal_store(w, (u32x4*)(rowp + bj * HALF)); } }
        } else {
            float* base = out + (col0 < 1024 ? O_MK : O_MV); const int c = col0 & 1023;
#pragma unroll
            for (int ai = 0; ai < 2; ++ai)
#pragma unroll
                for (int m = 0; m < 4; ++m) { float* rowp = base + (size_t)(row0 + ai * HALF + m * 16) * 1024 + c;
#pragma unroll
                    for (int bj = 0; bj < 2; ++bj) { *(f32x4*)(rowp + bj * HALF) = acc[ai][bj][m][0]; *(f32x4*)(rowp + bj * HALF + 4) = acc[ai][bj][m][1]; } }
        }
    }
};
struct EpiP3 {
    bf16_t* part[4];
    DI void operator()(const f32x4 (&acc)[2][2][4][2], const GUnit& u, int wr, int wc, int fr, int fq) const {
        const int row0 = u.pm * 256 + wr * 64 + fr, col0 = u.pn * 256 + wc * 32 + 8 * fq;
        bf16_t* base = u.aux == 0 ? part[0] : (u.aux == 1 ? part[1] : (u.aux == 2 ? part[2] : part[3]));
#pragma unroll
        for (int ai = 0; ai < 2; ++ai)
#pragma unroll
            for (int m = 0; m < 4; ++m) { bf16_t* rowp = base + (size_t)(row0 + ai * HALF + m * 16) * 1024 + col0;
#pragma unroll
                for (int bj = 0; bj < 2; ++bj) { const f32x4 v0 = acc[ai][bj][m][0], v1 = acc[ai][bj][m][1];
                    u32x4 w; w.x = pack_bf2(v0[0], v0[1]); w.y = pack_bf2(v0[2], v0[3]); w.z = pack_bf2(v1[0], v1[1]); w.w = pack_bf2(v1[2], v1[3]);
                    *(u32x4*)(rowp + bj * HALF) = w; } }
    }
};
struct EpiP4 {
    float* out; const float* xp; const float* xs; float* partq;
    DI void operator()(const f32x4 (&acc)[2][2][4][2], const GUnit& u, int wr, int wc, int fr, int fq) const {
        const int row0 = u.pm * 256 + wr * 64 + fr, col0 = u.pn * 256 + wc * 32 + 8 * fq;
#pragma unroll
        for (int ai = 0; ai < 2; ++ai)
#pragma unroll
            for (int m = 0; m < 4; ++m) { const int row = row0 + ai * HALF + m * 16;
                if (u.aux == 0) {
                    const float* xr = (row < NPROMPT ? xp + (size_t)row * 1024 : xs + (size_t)(row - NPROMPT) * 1024) + col0;
                    float* o = out + (size_t)row * 1024 + col0;
#pragma unroll
                    for (int bj = 0; bj < 2; ++bj) { *(f32x4*)(o + bj * HALF) = __builtin_nontemporal_load((const f32x4*)(xr + bj * HALF)) + acc[ai][bj][m][0]; *(f32x4*)(o + bj * HALF + 4) = __builtin_nontemporal_load((const f32x4*)(xr + bj * HALF + 4)) + acc[ai][bj][m][1]; }
                } else {
                    float* o = partq + ((size_t)(u.aux - 1) * 4096 + (row - 13312)) * 256 + (col0 - 768);
#pragma unroll
                    for (int bj = 0; bj < 2; ++bj) { *(f32x4*)(o + bj * HALF) = acc[ai][bj][m][0]; *(f32x4*)(o + bj * HALF + 4) = acc[ai][bj][m][1]; }
                } }
    }
};

DI bf16x8 tr_frag(const bf16_t* arr, int stride_elems, int k0, int c0, int lane) {
    const int h = lane >> 5, blk = (lane >> 4) & 1, q = (lane & 15) >> 2, pp = lane & 3;
    const unsigned a0 = (unsigned)(size_t)(arr + (k0 + 8 * h + q) * stride_elems + c0 + 16 * blk + 4 * pp);
    const unsigned a1 = a0 + 4u * (unsigned)stride_elems * 2u;
    u32x2 lo, hi;
    asm volatile("ds_read_b64_tr_b16 %0, %2\n\tds_read_b64_tr_b16 %1, %3\n\ts_waitcnt lgkmcnt(0)" : "=&v"(lo), "=&v"(hi) : "v"(a0), "v"(a1) : "memory");
    u32x4 w; w.x = lo.x; w.y = lo.y; w.z = hi.x; w.w = hi.y;
    return __builtin_bit_cast(bf16x8, w);
}
DI void tr_tile_wave(const float* src, int srcld, int srccol0, int k0, bf16_t* dst, int dstld, const float* kscale, float mul, bf16_t* tl, int lane) {
    const int kq = lane >> 4, n4 = (lane & 15) * 4;
    f32x4 v[16];
#pragma unroll
    for (int it = 0; it < 16; ++it) v[it] = __builtin_nontemporal_load((const f32x4*)(src + (size_t)(k0 + it * 4 + kq) * srcld + srccol0 + n4));
#pragma unroll
    for (int it = 0; it < 16; ++it) { const int k = it * 4 + kq; const float sc = (kscale ? kscale[k0 + k] : 1.0f) * mul;
        u32x2 w; w.x = pack_bf2(v[it][0] * sc, v[it][1] * sc); w.y = pack_bf2(v[it][2] * sc, v[it][3] * sc);
        *(u32x2*)(tl + k * 72 + n4) = w; }
    asm volatile("s_waitcnt lgkmcnt(0)" ::: "memory");
    const int r = lane & 31, h = lane >> 5;
#pragma unroll
    for (int c = 0; c < 2; ++c)
#pragma unroll
        for (int ks = 0; ks < 4; ++ks) { const bf16x8 f = tr_frag(tl, 72, ks * 16, c * 32, lane);
            *(bf16x8*)(dst + (size_t)(c * 32 + r) * dstld + k0 + ks * 16 + 8 * h) = f; }
}

DI void phase0(const Params& p, unsigned char* lds, const int wid_s) {
    const int tid = tid_opaque(wid_s), wid = tid >> 6, lane = tid & 63, G = gridDim.x, bid = blockIdx.x;
    unsigned char* ws = p.ws;
    if (bid == 0 && tid < 16) ((unsigned*)(ws + WS_CTR))[tid] = 0u;
    const int rank = wid * G + bid, NWK = 8 * G;
    bf16_t* tl = (bf16_t*)(lds + wid * 9216);
    for (int t = rank; t < 4944; t += NWK) {
        if (t >= 4928) { const int kt = t - 4928;
            tr_tile_wave(p.in[9], IN_COLS, 7168, kt * 64, (bf16_t*)(ws + WS_SSQP), 1024, nullptr, 1.0f, tl, lane); }
        else if (t < 3072) { const int nt_ = t >> 4, kt = t & 15; const int n0 = nt_ * 64; const int sc0 = n0 < C_Q ? n0 : n0 + 32;
            tr_tile_wave(p.in[9], IN_COLS, sc0, kt * 64, (bf16_t*)(ws + WS_WIN) + (size_t)n0 * 1024, 1024, nullptr, (n0 >= C_Q && n0 < C_AZ) ? 0.0625f : 1.0f, tl, lane); }
        else if (t < 3584) { const int u = t - 3072; const int nt_ = u >> 4, kt = u & 15; const int n0 = nt_ * 64;
            tr_tile_wave(n0 < 1024 ? p.in[19] : p.in[20], 1024, n0 & 1023, kt * 64, (bf16_t*)(ws + WS_WKV) + (size_t)n0 * 1024, 1024, nullptr, 1.0f, tl, lane); }
        else if (t < 4608) { const int u = t - 3584; const int nt_ = u >> 6, kt = u & 63; const int n0 = nt_ * 64, k0 = kt * 64;
            bf16_t* dst = (bf16_t*)(ws + WS_WCAT) + (size_t)n0 * 4096;
            if (k0 < 1024) tr_tile_wave(p.in[21], 1024, n0, k0, dst, 4096, nullptr, 1.0f, tl, lane);
            else if (k0 < 3072) tr_tile_wave(p.in[22], 1024, n0, k0 - 1024, dst + 1024, 4096, p.in[17], 1.0f, tl, lane);
            else tr_tile_wave(p.in[23], 1024, n0, k0 - 3072, dst + 3072, 4096, nullptr, 1.0f, tl, lane); }
        else if (t < 4864) { const int u = t - 4608; const int nt_ = u >> 4, kt = u & 15;
            tr_tile_wave(p.in[24], 1024, nt_ * 64, kt * 64, (bf16_t*)(ws + WS_WO) + (size_t)nt_ * 64 * 1024, 1024, nullptr, 1.0f, tl, lane); }
        else { const int u = t - 4864; const int g = u >> 4, nt_ = (u >> 2) & 3, kt = u & 3;
            tr_tile_wave(p.in[10] + (size_t)g * 65536, 256, nt_ * 64, kt * 64, (bf16_t*)(ws + WS_WPG) + (size_t)g * 65536 + (size_t)nt_ * 64 * 256, 256, nullptr, 1.0f, tl, lane); }
    }
    for (int row = rank; row < NTOK + 2048; row += NWK) {
        const float* src; const float* w; bf16_t* dst;
        if (row < NTOK) { src = xrow(p, row); w = p.in[8]; dst = (bf16_t*)(ws + WS_H) + (size_t)row * 1024; }
        else { src = p.in[2] + (size_t)(row - NTOK) * 1024; w = p.in[18]; dst = (bf16_t*)(ws + WS_MH) + (size_t)(row - NTOK) * 1024; }
        f32x4 v[4]; float ss = 0.f;
#pragma unroll
        for (int j = 0; j < 4; ++j) { v[j] = __builtin_nontemporal_load((const f32x4*)(src + j * 256 + lane * 4)); ss += v[j][0] * v[j][0] + v[j][1] * v[j][1] + v[j][2] * v[j][2] + v[j][3] * v[j][3]; }
#pragma unroll
        for (int o = 32; o > 0; o >>= 1) ss += __shfl_xor(ss, o);
        const float rs = rsqrtf(ss * (1.0f / 1024.0f) + EPS);
#pragma unroll
        for (int j = 0; j < 4; ++j) { const f32x4 wv = *(const f32x4*)(w + j * 256 + lane * 4);
            u32x2 o2; o2.x = pack_bf2(v[j][0] * rs * wv[0], v[j][1] * rs * wv[1]); o2.y = pack_bf2(v[j][2] * rs * wv[2], v[j][3] * rs * wv[3]);
            *(u32x2*)(dst + j * 256 + lane * 4) = o2; }
    }
}

#define SSD_DRY (PROBE == 3 && ((volatile int*)(lds + QSLOT_OFF))[1] != 0)
#define SSD_LVL ((PROBE == 3) ? ((volatile int*)(lds + QSLOT_OFF))[1] : 0)
#ifndef PROBE_LVL
#define PROBE_LVL 1
#endif
DI void ssd_prompt_item(const Params& p, unsigned char* lds, int item, const int wid_s) {
    const int tid = tid_opaque(wid_s), wid = tid >> 6, lane = tid & 63, r = lane & 31, hh = lane >> 5;
    const int b = item >> 5, head = item & 31, g = head >> 3;
    bf16_t* proj = (bf16_t*)(p.ws + WS_PROJ);
    const bf16_t* bcb = (const bf16_t*)(p.ws + WS_PART3);
    const float* dtbuf = (const float*)(p.ws + WS_DT);
    const float Ah = -__expf(p.in[15][head]);
    const float Dh = p.in[16][head];
    const float* convw = p.in[12]; const float* convb = p.in[13];
    bf16_t* Cs = (bf16_t*)lds;
    bf16_t* Bs = Cs + 128 * 136;
    bf16_t* Ms = Bs + 128 * 136;
    bf16_t* xs = Ms + 128 * 136;
    bf16_t* hb = xs + 128 * 72;
    float* acs = (float*)(hb + 64 * 136);
    float* wk = acs + 128; float* dtv = wk + 128; float* eacs = dtv + 128; float* cw = eacs + 128;
    f32x16 hacc; for (int i = 0; i < 16; ++i) hacc[i] = 0.f;
    const int pt = wid >> 2, ntl = wid & 3;
    const int qt = wid >> 1, t2 = wid & 1;
    const int j0 = wid, j1 = 8 + wid;
    const int gq0 = j0 < 1 ? 0 : (j0 < 3 ? 1 : (j0 < 6 ? 2 : 3)), gk0 = j0 - gq0 * (gq0 + 1) / 2;
    const int gq1 = 3, gk1 = j1 - 6;
    const bool two = wid < 2;
    const int xpair = tid & 31, xseg = tid >> 5;
    const int xch = head * 64 + 2 * xpair;
    if (tid < 64) {
#pragma unroll
        for (int k = 0; k < 4; ++k) cw[k * 64 + tid] = convw[k * 3072 + head * 64 + tid];
        cw[4 * 64 + tid] = convb[head * 64 + tid]; }
    const unsigned roff0 = (unsigned)(b * 2048 + xseg * 8 - 3) * PC + C_XBC + xch;
    const unsigned boff0 = (unsigned)(b * 2048 + (tid >> 5)) * 1024 + g * 128 + ((tid & 31) >> 4) * 512 + (tid & 15) * 8;
    const unsigned zoff0 = (unsigned)(b * 2048 + qt * 32 + r) * PC + C_SZ + head * 64 + t2 * 32 + 4 * hh;
    unsigned raw[11]; u32x4 bcv[8]; u32x2 zr[4]; float dtc0 = 0.f, dtc1 = 0.f;
#pragma unroll
    for (int i = 0; i < 11; ++i) { const int t = xseg * 8 - 3 + i; raw[i] = (t >= 0) ? *(const unsigned*)(proj + (roff0 + (unsigned)(i * PC))) : 0u; }
#pragma unroll
    for (int j = 0; j < 8; ++j) bcv[j] = *(const u32x4*)(bcb + (boff0 + (unsigned)(j * 16 * 1024)));
#pragma unroll
    for (int gq = 0; gq < 4; ++gq) zr[gq] = *(const u32x2*)(proj + (zoff0 + (unsigned)(8 * gq)));
    if (wid == 0) { dtc0 = dtbuf[(size_t)(b * 2048 + 2 * lane) * 32 + head]; dtc1 = dtbuf[(size_t)(b * 2048 + 2 * lane + 1) * 32 + head]; }
    lds_barrier();
    for (int c = 0; c < 16; ++c) {
        const int R0 = b * 2048 + c * 128;
        if (wid == 0) {
            const float a0 = dtc0 * Ah, a1 = dtc1 * Ah; float s = a0 + a1;
#define SCAN_DPP(ctrl, rmask) s += __builtin_bit_cast(float, __builtin_amdgcn_update_dpp(0, __builtin_bit_cast(int, s), (ctrl), (rmask), 0xf, false))
            SCAN_DPP(0x111, 0xf); SCAN_DPP(0x112, 0xf); SCAN_DPP(0x114, 0xf); SCAN_DPP(0x118, 0xf); SCAN_DPP(0x142, 0xa); SCAN_DPP(0x143, 0xc);
#undef SCAN_DPP
            const float tot = __shfl(s, 63); const float s0 = s - a1;
            acs[2 * lane] = s0; acs[2 * lane + 1] = s; wk[2 * lane] = dtc0 * __expf(tot - s0); wk[2 * lane + 1] = dtc1 * __expf(tot - s);
            dtv[2 * lane] = dtc0; dtv[2 * lane + 1] = dtc1; eacs[2 * lane] = __expf(s0); eacs[2 * lane + 1] = __expf(s);
            if (c < 15) { dtc0 = dtbuf[(size_t)(R0 + 128 + 2 * lane) * 32 + head]; dtc1 = dtbuf[(size_t)(R0 + 128 + 2 * lane + 1) * 32 + head]; }
        }
        {
            float w0[4], w1[4];
#pragma unroll
            for (int k = 0; k < 4; ++k) { const f32x2 t = *(const f32x2*)(cw + k * 64 + 2 * xpair); w0[k] = t[0]; w1[k] = t[1]; }
            const f32x2 bt = *(const f32x2*)(cw + 4 * 64 + 2 * xpair); const float b0 = bt[0], b1 = bt[1];
#pragma unroll
            for (int i = 0; i < 8; ++i) {
                float o0 = b0, o1 = b1;
#pragma unroll
                for (int k = 0; k < 4; ++k) { o0 += w0[k] * __uint_as_float(raw[i + k] << 16); o1 += w1[k] * __uint_as_float(raw[i + k] & 0xffff0000u); }
                o0 = silu_f(o0); o1 = silu_f(o1);
                const int k = xseg * 8 + i;
                *(unsigned*)(xs + k * 72 + 2 * xpair) = pack_bf2(o0, o1);
            }
#pragma unroll
            for (int j = 0; j < 8; ++j) { const int id = tid + 512 * j, row = id >> 5, part = id & 31;
                if (part < 16) *(u32x4*)(Bs + row * 136 + part * 8) = bcv[j]; else *(u32x4*)(Cs + row * 136 + (part - 16) * 8) = bcv[j]; }
        }
        lds_barrier();
        f32x16 yoff;
        for (int i = 0; i < 16; ++i) yoff[i] = 0.f;
        if (c > 0) {
#pragma unroll
            for (int kk = 0; kk < 8; ++kk) { const bf16x8 a = *(const bf16x8*)(Cs + (qt * 32 + r) * 136 + kk * 16 + 8 * hh); const bf16x8 bb = *(const bf16x8*)(hb + (t2 * 32 + r) * 136 + kk * 16 + 8 * hh);
                yoff = MFMA32(bb, a, yoff); } }
        for (int job = 0; job < (two ? 2 : 1); ++job) {
            const int gq = job ? gq1 : gq0, gk = job ? gk1 : gk0;
            f32x16 ga; for (int i = 0; i < 16; ++i) ga[i] = 0.f;
#pragma unroll
            for (int kk = 0; kk < 8; ++kk) { const bf16x8 a = *(const bf16x8*)(Cs + (gq * 32 + r) * 136 + kk * 16 + 8 * hh); const bf16x8 bb = *(const bf16x8*)(Bs + (gk * 32 + r) * 136 + kk * 16 + 8 * hh);
                ga = MFMA32(bb, a, ga); }
            const int q = gq * 32 + r; const float aq = acs[q];
#pragma unroll
            for (int g4 = 0; g4 < 4; ++g4) { const int k4 = gk * 32 + 8 * g4 + 4 * hh; const f32x4 ak = *(const f32x4*)(acs + k4), dk = *(const f32x4*)(dtv + k4);
                float v[4];
#pragma unroll
                for (int j = 0; j < 4; ++j) v[j] = (k4 + j <= q) ? ga[4 * g4 + j] * __expf(aq - ak[j]) * dk[j] : 0.f;
                u32x2 o; o.x = pack_bf2(v[0], v[1]); o.y = pack_bf2(v[2], v[3]); *(u32x2*)(Ms + q * 136 + k4) = o; }
        }
        lds_barrier();
        {
            f32x16 yd; for (int i = 0; i < 16; ++i) yd[i] = 0.f;
#pragma unroll
            for (int kk = 0; kk < 8; ++kk) if (kk < 2 * (qt + 1)) { const bf16x8 a = *(const bf16x8*)(Ms + (qt * 32 + r) * 136 + kk * 16 + 8 * hh); const bf16x8 bb = tr_frag(xs, 72, kk * 16, t2 * 32, lane);
                yd = MFMA32(bb, a, yd); }
            const int q = qt * 32 + r; const float eq = eacs[q];
            unsigned zo = zoff0 + (unsigned)(c * 128 * PC); asm volatile("" : "+v"(zo));
#pragma unroll
            for (int gq = 0; gq < 4; ++gq) { const int p4 = t2 * 32 + 8 * gq + 4 * hh;
                const u32x2 xv = *(const u32x2*)(xs + q * 72 + p4); const u32x2 z = zr[gq];
                const float y0 = eq * yoff[4 * gq] + yd[4 * gq] + Dh * __uint_as_float(xv.x << 16), y1 = eq * yoff[4 * gq + 1] + yd[4 * gq + 1] + Dh * __uint_as_float(xv.x & 0xffff0000u);
                const float y2 = eq * yoff[4 * gq + 2] + yd[4 * gq + 2] + Dh * __uint_as_float(xv.y << 16), y3 = eq * yoff[4 * gq + 3] + yd[4 * gq + 3] + Dh * __uint_as_float(xv.y & 0xffff0000u);
                u32x2 o; o.x = pack_bf2(y0 * __uint_as_float(z.x << 16), y1 * __uint_as_float(z.x & 0xffff0000u)); o.y = pack_bf2(y2 * __uint_as_float(z.y << 16), y3 * __uint_as_float(z.y & 0xffff0000u));
                if (!SSD_DRY) *(u32x2*)(proj + (zo + (unsigned)(8 * gq))) = o; }
            if (c < 15) { zo += (unsigned)(128 * PC);
#pragma unroll
                for (int gq = 0; gq < 4; ++gq) zr[gq] = *(const u32x2*)(proj + (zo + (unsigned)(8 * gq))); }
        }
        if (c < 15) {
            unsigned ro = roff0 + (unsigned)((c + 1) * 128 * PC); asm volatile("" : "+v"(ro));
#pragma unroll
            for (int i = 0; i < 11; ++i) raw[i] = *(const unsigned*)(proj + (ro + (unsigned)(i * PC)));
            unsigned bo = boff0 + (unsigned)((c + 1) * 128 * 1024); asm volatile("" : "+v"(bo));
#pragma unroll
            for (int j = 0; j < 8; ++j) bcv[j] = *(const u32x4*)(bcb + (bo + (unsigned)(j * 16 * 1024)));
        }
        {
            const float cd = eacs[127];
#pragma unroll
            for (int i = 0; i < 16; ++i) hacc[i] *= cd;
#pragma unroll
            for (int kk = 0; kk < 8; ++kk) { const u32x4 xa = __builtin_bit_cast(u32x4, tr_frag(xs, 72, kk * 16, pt * 32, lane)); const bf16x8 bb = tr_frag(Bs, 136, kk * 16, ntl * 32, lane);
                const f32x4 wa = *(const f32x4*)(wk + kk * 16 + 8 * hh), wb = *(const f32x4*)(wk + kk * 16 + 8 * hh + 4);
                u32x4 xsc; xsc.x = pack_bf2(__uint_as_float(xa.x << 16) * wa[0], __uint_as_float(xa.x & 0xffff0000u) * wa[1]); xsc.y = pack_bf2(__uint_as_float(xa.y << 16) * wa[2], __uint_as_float(xa.y & 0xffff0000u) * wa[3]);
                xsc.z = pack_bf2(__uint_as_float(xa.z << 16) * wb[0], __uint_as_float(xa.z & 0xffff0000u) * wb[1]); xsc.w = pack_bf2(__uint_as_float(xa.w << 16) * wb[2], __uint_as_float(xa.w & 0xffff0000u) * wb[3]);
                hacc = MFMA32(bb, __builtin_bit_cast(bf16x8, xsc), hacc); }
#pragma unroll
            for (int g4 = 0; g4 < 4; ++g4) { u32x2 o; o.x = pack_bf2(hacc[4 * g4], hacc[4 * g4 + 1]); o.y = pack_bf2(hacc[4 * g4 + 2], hacc[4 * g4 + 3]);
                *(u32x2*)(hb + (pt * 32 + r) * 136 + ntl * 32 + 8 * g4 + 4 * hh) = o; }
        }
        lds_barrier();
    }
    float* so = p.out + O_SSMP + (size_t)(b * 32 + head) * 8192;
#pragma unroll
    for (int g4 = 0; g4 < 4; ++g4) if (!SSD_DRY) *(f32x4*)(so + (pt * 32 + r) * 128 + ntl * 32 + 8 * g4 + 4 * hh) = (f32x4){hacc[4 * g4], hacc[4 * g4 + 1], hacc[4 * g4 + 2], hacc[4 * g4 + 3]};
}

DI void bc_conv_pass(const Params& p, const int wid_s) {
    const int tid = tid_opaque(wid_s), G = gridDim.x, bid = blockIdx.x;
    { const int wid = tid >> 6, lane = tid & 63, r = lane & 31, hh = lane >> 5;
      for (int T = bid + G * wid; T < NTOK / 32; T += G * 8) {
          const bf16_t* ap = (const bf16_t*)(p.ws + WS_H) + (size_t)(T * 32 + r) * 1024 + 8 * hh;
          const bf16_t* bp = (const bf16_t*)(p.ws + WS_SSQP) + (size_t)r * 1024 + 8 * hh;
          f32x16 acc; for (int i = 0; i < 16; ++i) acc[i] = 0.f;
#pragma unroll 8
          for (int kk = 0; kk < 64; ++kk) acc = MFMA32(*(const bf16x8*)(ap + kk * 16), *(const bf16x8*)(bp + kk * 16), acc);
          const float bias = p.in[14][r]; float* dtb = (float*)(p.ws + WS_DT);
#pragma unroll
          for (int i = 0; i < 16; ++i) { const float v = acc[i] + bias; dtb[(size_t)(T * 32 + crow(i, hh)) * 32 + r] = v > 20.f ? v : log1pf(__expf(v)); }
      } }
    const bf16_t* proj = (const bf16_t*)(p.ws + WS_PROJ);
    bf16_t* bcb = (bf16_t*)(p.ws + WS_PART3);
    const float* convw = p.in[12]; const float* convb = p.in[13];
    for (int task = bid * 512 + tid; task < 1024 * 512; task += G * 512) {
        const int cp = task & 511, sg = task >> 9; const int ch = 2048 + 2 * cp; const int R = sg * 16, pos = R & 2047;
        const bf16_t* src = proj + (size_t)R * PC + C_XBC + ch;
        unsigned raw[19];
#pragma unroll
        for (int i = 0; i < 19; ++i) raw[i] = (pos + i - 3 >= 0) ? __builtin_nontemporal_load((const unsigned*)(src + (ptrdiff_t)(i - 3) * PC)) : 0u;
        float w0[4], w1[4];
#pragma unroll
        for (int k = 0; k < 4; ++k) { w0[k] = convw[k * 3072 + ch]; w1[k] = convw[k * 3072 + ch + 1]; }
        const float b0 = convb[ch], b1 = convb[ch + 1];
#pragma unroll
        for (int i = 0; i < 16; ++i) { float o0 = b0, o1 = b1;
#pragma unroll
            for (int k = 0; k < 4; ++k) { o0 += w0[k] * __uint_as_float(raw[i + k] << 16); o1 += w1[k] * __uint_as_float(raw[i + k] & 0xffff0000u); }
            *(unsigned*)(bcb + (size_t)(R + i) * 1024 + 2 * cp) = pack_bf2(silu_f(o0), silu_f(o1)); }
    }
    for (int task = bid * 512 + tid; task < 128 * 512; task += G * 512) {
        const int cp = task & 511, bs = task >> 9; const int ch = 2048 + 2 * cp; const int R = NPROMPT + bs * 8;
        float e0[11], e1[11];
#pragma unroll
        for (int j = 0; j < 3; ++j) { const f32x2 sv = *(const f32x2*)(p.in[4] + ((size_t)bs * 3 + j) * 3072 + ch); e0[j] = sv[0]; e1[j] = sv[1]; }
#pragma unroll
        for (int k = 0; k < 8; ++k) { const unsigned v = *(const unsigned*)(proj + (size_t)(R + k) * PC + C_XBC + ch); e0[3 + k] = __uint_as_float(v << 16); e1[3 + k] = __uint_as_float(v & 0xffff0000u); }
        float w0[4], w1[4];
#pragma unroll
        for (int k = 0; k < 4; ++k) { w0[k] = convw[k * 3072 + ch]; w1[k] = convw[k * 3072 + ch + 1]; }
        const float b0 = convb[ch], b1 = convb[ch + 1];
#pragma unroll
        for (int i = 0; i < 8; ++i) { float o0 = b0, o1 = b1;
#pragma unroll
            for (int k = 0; k < 4; ++k) { o0 += w0[k] * e0[i + k]; o1 += w1[k] * e1[i + k]; }
            *(unsigned*)(bcb + (size_t)(R + i) * 1024 + 2 * cp) = pack_bf2(silu_f(o0), silu_f(o1)); }
    }
}

DI void ssd_sample_item(const Params& p, unsigned char* lds, int item, const int wid_s, const bool dry = false) {
    const int tid = tid_opaque(wid_s), wid = tid >> 6, lane = tid & 63;
    const int pair = item * 8 + wid, b = pair >> 5, head = pair & 31, g = head >> 3;
    bf16_t* proj = (bf16_t*)(p.ws + WS_PROJ);
    const float* dtbuf = (const float*)(p.ws + WS_DT);
    const float Ah = -__expf(p.in[15][head]);
    const float Dh = p.in[16][head];
    const float* convw = p.in[12]; const float* convb = p.in[13];
    const int R0 = NPROMPT + b * 8;
    float* L = (float*)(lds + wid * 12800);
    float* xw = L;
    float* Bv = xw + 512;
    float* Cv = Bv + 1024;
    float* Mm = Cv + 1024;
    float* Yo = Mm + 64;
    float* sc = Yo + 512;
    float dtk[8], acs[8], eq[8], wv[8];
    { float s = 0.f;
#pragma unroll
        for (int k = 0; k < 8; ++k) { dtk[k] = dtbuf[(size_t)(R0 + k) * 32 + head]; s += dtk[k] * Ah; acs[k] = s; }
#pragma unroll
        for (int k = 0; k < 8; ++k) { eq[k] = __expf(acs[k]); wv[k] = dtk[k] * __expf(acs[7] - acs[k]); } }
    const float cd = __expf(acs[7]);
    if (lane < 8) { sc[lane] = acs[0]; }
#pragma unroll
    for (int k = 0; k < 8; ++k) if (lane == k) { sc[k] = acs[k]; sc[8 + k] = dtk[k]; }
    float xs[8];
    const float* sconv = p.in[4] + (size_t)b * 3 * 3072;
    { const int ch = head * 64 + lane;
        float e[11];
#pragma unroll
        for (int j = 0; j < 3; ++j) e[j] = sconv[j * 3072 + ch];
#pragma unroll
        for (int k = 0; k < 8; ++k) e[3 + k] = bf2f(proj[(size_t)(R0 + k) * PC + C_XBC + ch]);
        const float w0 = convw[ch], w1 = convw[3072 + ch], w2 = convw[2 * 3072 + ch], w3 = convw[3 * 3072 + ch], bb = convb[ch];
#pragma unroll
        for (int k = 0; k < 8; ++k) { const float o = silu_f(bb + w0 * e[k] + w1 * e[k + 1] + w2 * e[k + 2] + w3 * e[k + 3]); xs[k] = o; xw[lane * 8 + k] = o * wv[k]; }
        const bf16_t* bcb = (const bf16_t*)(p.ws + WS_PART3) + (size_t)R0 * 1024 + g * 128;
#pragma unroll
        for (int k = 0; k < 8; ++k) { const unsigned vb = *(const unsigned*)(bcb + (size_t)k * 1024 + 2 * lane), vc = *(const unsigned*)(bcb + (size_t)k * 1024 + 512 + 2 * lane);
            *(f32x2*)(Bv + k * 128 + 2 * lane) = (f32x2){__uint_as_float(vb << 16), __uint_as_float(vb & 0xffff0000u)};
            *(f32x2*)(Cv + k * 128 + 2 * lane) = (f32x2){__uint_as_float(vc << 16), __uint_as_float(vc & 0xffff0000u)}; }
    }
    lds_barrier();
    { const int q = lane >> 3, k = lane & 7; float gsum = 0.f;
        if (k <= q) {
            for (int n = 0; n < 128; n += 4) { const f32x4 cv = *(const f32x4*)(Cv + q * 128 + n); const f32x4 bv = *(const f32x4*)(Bv + k * 128 + n);
                gsum += cv[0] * bv[0] + cv[1] * bv[1] + cv[2] * bv[2] + cv[3] * bv[3]; }
            gsum *= __expf(sc[q] - sc[k]) * sc[8 + k];
        }
        Mm[lane] = gsum; }
    lds_barrier();
    float yd[8];
#pragma unroll
    for (int q = 0; q < 8; ++q) { float s = 0.f;
#pragma unroll
        for (int k = 0; k < 8; ++k) s += Mm[q * 8 + k] * xs[k];
        yd[q] = s; }
    const int half = lane >> 5, nl = lane & 31;
    f32x4 Bq[8], Cq[8];
#pragma unroll
    for (int k = 0; k < 8; ++k) { Bq[k] = *(const f32x4*)(Bv + k * 128 + 4 * nl); Cq[k] = *(const f32x4*)(Cv + k * 128 + 4 * nl); }
    const float* h0 = p.in[5] + (size_t)pair * 8192;
    float* hn = p.out + O_SSMS + (size_t)pair * 8192;
    for (int i0 = 0; i0 < 32; i0 += 8) {
        f32x4 hv[8];
#pragma unroll
        for (int u = 0; u < 8; ++u) hv[u] = __builtin_nontemporal_load((const f32x4*)(h0 + (2 * (i0 + u) + half) * 128 + 4 * nl));
#pragma unroll
        for (int u = 0; u < 8; ++u) {
            const int pp = 2 * (i0 + u) + half;
            float v[8];
#pragma unroll
            for (int q = 0; q < 8; ++q) v[q] = Cq[q][0] * hv[u][0] + Cq[q][1] * hv[u][1] + Cq[q][2] * hv[u][2] + Cq[q][3] * hv[u][3];
            float v4[4], v2[2], v1;
            const bool b4 = (nl & 16) != 0, b3 = (nl & 8) != 0, b2 = (nl & 4) != 0;
#pragma unroll
            for (int j = 0; j < 4; ++j) { const float send = b4 ? v[j] : v[j + 4], keep = b4 ? v[j + 4] : v[j]; v4[j] = keep + xchg16(send, b4); }
#pragma unroll
            for (int j = 0; j < 2; ++j) { const float send = b3 ? v4[j] : v4[j + 2], keep = b3 ? v4[j + 2] : v4[j]; v2[j] = keep + xchg8(send); }
            { const float send = b2 ? v2[0] : v2[1], keep = b2 ? v2[1] : v2[0]; v1 = keep + xchg_hm(send); }
            v1 = dpp_add_x1(v1); v1 = dpp_add_x2(v1);
            if ((nl & 3) == 0) Yo[pp * 8 + (nl >> 2)] = v1;
            const f32x4 xa = *(const f32x4*)(xw + pp * 8), xb = *(const f32x4*)(xw + pp * 8 + 4);
            f32x4 hnew = hv[u] * cd;
            hnew += Bq[0] * xa[0]; hnew += Bq[1] * xa[1]; hnew += Bq[2] * xa[2]; hnew += Bq[3] * xa[3];
            hnew += Bq[4] * xb[0]; hnew += Bq[5] * xb[1]; hnew += Bq[6] * xb[2]; hnew += Bq[7] * xb[3];
            if (!dry) __builtin_nontemporal_store(hnew, (f32x4*)(hn + pp * 128 + 4 * nl));
        }
    }
    lds_barrier();
#pragma unroll
    for (int q = 0; q < 8; ++q) {
        const float y = eq[q] * Yo[lane * 8 + q] + yd[q] + Dh * xs[q];
        const size_t addr = (size_t)(R0 + q) * PC + C_SZ + head * 64 + lane;
        if (!dry) proj[addr] = f2bf(y * bf2f(proj[addr]));
    }
}

DI void attn_prompt_item(const Params& p, unsigned char* lds, int item, const int wid_s, const bool dry = false) {
    const int tid = tid_opaque(wid_s), wid = tid >> 6, lane = tid & 63, r = lane & 31, hh = lane >> 5;
    const int b = item >> 5, h = (item >> 3) & 3, qt = item & 7;
    bf16_t* proj = (bf16_t*)(p.ws + WS_PROJ);
    const int R0 = b * 2048 + qt * 256 + wid * 32;
    bf16_t* Ks = (bf16_t*)lds;
    bf16_t* VT = Ks + 256 * 72;
    const float* Kg = p.out + O_MK + (size_t)(b * 256) * 1024 + h * 256;
    const float* Vg = p.out + O_MV + (size_t)(b * 256) * 1024 + h * 256;
    f32x16 sacc[8];
#pragma unroll
    for (int kt = 0; kt < 8; ++kt) for (int i = 0; i < 16; ++i) sacc[kt][i] = 0.f;
    const bf16_t* qrow = proj + (size_t)(R0 + r) * PC + C_Q + h * 256 + 8 * hh;
    const int skey = tid >> 1, sd0 = (tid & 1) * 32;
    f32x4 stg[8];
#pragma unroll
    for (int j = 0; j < 8; ++j) stg[j] = *(const f32x4*)(Kg + (size_t)skey * 1024 + sd0 + 4 * j);
    for (int dc = 0; dc < 4; ++dc) {
        bf16x8 bq[4];
#pragma unroll
        for (int kk = 0; kk < 4; ++kk) bq[kk] = *(const bf16x8*)(qrow + dc * 64 + kk * 16);
#pragma unroll
        for (int j = 0; j < 4; ++j) { const f32x4 a = stg[2 * j], c4 = stg[2 * j + 1];
            u32x4 w; w.x = pack_bf2(a[0], a[1]); w.y = pack_bf2(a[2], a[3]); w.z = pack_bf2(c4[0], c4[1]); w.w = pack_bf2(c4[2], c4[3]);
            *(u32x4*)(Ks + skey * 72 + sd0 + 8 * j) = w; }
        lds_barrier();
        if (dc < 3) {
#pragma unroll
            for (int j = 0; j < 8; ++j) stg[j] = *(const f32x4*)(Kg + (size_t)skey * 1024 + (dc + 1) * 64 + sd0 + 4 * j); }
#pragma unroll
        for (int kt = 0; kt < 8; ++kt)
#pragma unroll
            for (int kk = 0; kk < 4; ++kk) { const bf16x8 a = *(const bf16x8*)(Ks + (kt * 32 + r) * 72 + kk * 16 + 8 * hh); sacc[kt] = MFMA32(a, bq[kk], sacc[kt]); }
        lds_barrier();
    }
    const int vdg = tid & 15, vkb = tid >> 4;
#pragma unroll
    for (int it = 0; it < 8; ++it) stg[it] = *(const f32x4*)(Vg + (size_t)(vkb + 32 * it) * 1024 + 4 * vdg);
    float m = -3.0e38f;
#pragma unroll
    for (int kt = 0; kt < 8; ++kt)
#pragma unroll
        for (int i = 0; i < 16; ++i) m = fmaxf(m, sacc[kt][i]);
    m = fmaxf(m, __shfl_xor(m, 32));
    float l = 0.f;
#pragma unroll
    for (int kt = 0; kt < 8; ++kt)
#pragma unroll
        for (int i = 0; i < 16; ++i) { const float e = __expf(sacc[kt][i] - m); sacc[kt][i] = e; l += e; }
    l += __shfl_xor(l, 32);
    const float inv = 1.0f / l;
    bf16x8 pk[8][2];
#pragma unroll
    for (int kt = 0; kt < 8; ++kt)
#pragma unroll
        for (int s = 0; s < 2; ++s) { u32x4 w; w.x = pack_bf2(sacc[kt][8 * s], sacc[kt][8 * s + 1]); w.y = pack_bf2(sacc[kt][8 * s + 2], sacc[kt][8 * s + 3]);
            w.z = pack_bf2(sacc[kt][8 * s + 4], sacc[kt][8 * s + 5]); w.w = pack_bf2(sacc[kt][8 * s + 6], sacc[kt][8 * s + 7]); pk[kt][s] = __builtin_bit_cast(bf16x8, w); }
    for (int dc = 0; dc < 4; ++dc) {
#pragma unroll
        for (int it = 0; it < 8; ++it) { const int key = vkb + 32 * it;
#pragma unroll
            for (int j = 0; j < 4; ++j) VT[(4 * vdg + j) * 260 + key] = f2bf(stg[it][j]); }
        lds_barrier();
        if (dc < 3) {
#pragma unroll
            for (int it = 0; it < 8; ++it) stg[it] = *(const f32x4*)(Vg + (size_t)(vkb + 32 * it) * 1024 + (dc + 1) * 64 + 4 * vdg); }
        u32x2 zv[8];
#pragma unroll
        for (int d2 = 0; d2 < 2; ++d2)
#pragma unroll
            for (int gq = 0; gq < 4; ++gq) zv[d2 * 4 + gq] = *(const u32x2*)(proj + (size_t)(R0 + r) * PC + h * 256 + dc * 64 + d2 * 32 + 8 * gq + 4 * hh + C_AZ);
        f32x16 oacc[2];
#pragma unroll
        for (int d2 = 0; d2 < 2; ++d2) for (int i = 0; i < 16; ++i) oacc[d2][i] = 0.f;
#pragma unroll
        for (int kt = 0; kt < 8; ++kt)
#pragma unroll
            for (int s2 = 0; s2 < 2; ++s2)
#pragma unroll
                for (int d2 = 0; d2 < 2; ++d2) { const bf16_t* vr = VT + (d2 * 32 + r) * 260 + kt * 32 + 16 * s2 + 4 * hh;
                    const u32x2 lo = *(const u32x2*)vr, hi = *(const u32x2*)(vr + 8); u32x4 w; w.x = lo.x; w.y = lo.y; w.z = hi.x; w.w = hi.y;
                    oacc[d2] = MFMA32(__builtin_bit_cast(bf16x8, w), pk[kt][s2], oacc[d2]); }
#pragma unroll
        for (int d2 = 0; d2 < 2; ++d2)
#pragma unroll
            for (int gq = 0; gq < 4; ++gq) { const int d = dc * 64 + d2 * 32 + 8 * gq + 4 * hh;
                const size_t rowb = (size_t)(R0 + r) * PC + h * 256 + d;
                const u32x2 z = zv[d2 * 4 + gq];
                u32x2 o; o.x = pack_bf2(oacc[d2][4 * gq] * inv * __uint_as_float(z.x << 16), oacc[d2][4 * gq + 1] * inv * __uint_as_float(z.x & 0xffff0000u));
                o.y = pack_bf2(oacc[d2][4 * gq + 2] * inv * __uint_as_float(z.y << 16), oacc[d2][4 * gq + 3] * inv * __uint_as_float(z.y & 0xffff0000u));
                if (!dry) *(u32x2*)(proj + rowb + C_Q) = o; }
        lds_barrier();
    }
}

DI void attn_sample_item(const Params& p, unsigned char* lds, int item, const int wid_s, const bool dry = false) {
    const int tid = tid_opaque(wid_s), wid = tid >> 6, lane = tid & 63;
    const int b = item >> 2, h = item & 3;
    bf16_t* proj = (bf16_t*)(p.ws + WS_PROJ);
    const int R0 = NPROMPT + b * 8;
    float* S = (float*)lds;
    float* P = S + 2048;
    float* red = P + 2048;
    const float* Kg = p.in[6] + ((size_t)(b * 256) * 4 + h) * 256;
    const float* Vg = p.in[7] + ((size_t)(b * 256) * 4 + h) * 256;
    f32x4 q4[8];
#pragma unroll
    for (int q = 0; q < 8; ++q) { const u32x2 w = *(const u32x2*)(proj + (size_t)(R0 + q) * PC + C_Q + h * 256 + 4 * lane);
        q4[q] = (f32x4){__uint_as_float(w.x << 16), __uint_as_float(w.x & 0xffff0000u), __uint_as_float(w.y << 16), __uint_as_float(w.y & 0xffff0000u)}; }
    const bool b5 = (lane & 32) != 0, b4 = (lane & 16) != 0, b3 = (lane & 8) != 0;
    for (int k0 = 0; k0 < 32; k0 += 16) {
        f32x4 kv[16];
#pragma unroll
        for (int u = 0; u < 16; ++u) kv[u] = __builtin_nontemporal_load((const f32x4*)(Kg + (size_t)(wid * 32 + k0 + u) * 1024 + 4 * lane));
#pragma unroll
        for (int u = 0; u < 16; ++u) {
            float v[8];
#pragma unroll
            for (int q = 0; q < 8; ++q) v[q] = q4[q][0] * kv[u][0] + q4[q][1] * kv[u][1] + q4[q][2] * kv[u][2] + q4[q][3] * kv[u][3];
            float v4[4], v2[2], v1;
#pragma unroll
            for (int j = 0; j < 4; ++j) { const float send = b5 ? v[j] : v[j + 4], keep = b5 ? v[j + 4] : v[j]; v4[j] = keep + xchg32(send, b5); }
#pragma unroll
            for (int j = 0; j < 2; ++j) { const float send = b4 ? v4[j] : v4[j + 2], keep = b4 ? v4[j + 2] : v4[j]; v2[j] = keep + xchg16(send, b4); }
            { const float send = b3 ? v2[0] : v2[1], keep = b3 ? v2[1] : v2[0]; v1 = keep + xchg8(send); }
            v1 = dpp_add_x1(v1); v1 = dpp_add_x2(v1); v1 = dpp_add_hm(v1);
            if ((lane & 7) == 0) S[(lane >> 3) * 256 + wid * 32 + k0 + u] = v1;
        }
    }
    lds_barrier();
    { const f32x4 s4 = *(const f32x4*)(S + wid * 256 + 4 * lane);
        float m = fmaxf(fmaxf(s4[0], s4[1]), fmaxf(s4[2], s4[3]));
#pragma unroll
        for (int o = 32; o > 0; o >>= 1) m = fmaxf(m, __shfl_xor(m, o));
        f32x4 e; float l = 0.f;
#pragma unroll
        for (int j = 0; j < 4; ++j) { e[j] = __expf(s4[j] - m); l += e[j]; }
#pragma unroll
        for (int o = 32; o > 0; o >>= 1) l += __shfl_xor(l, o);
        const float inv = 1.0f / l;
#pragma unroll
        for (int j = 0; j < 4; ++j) P[(4 * lane + j) * 8 + wid] = e[j] * inv; }
    lds_barrier();
    f32x4 oa[8];
#pragma unroll
    for (int q = 0; q < 8; ++q) oa[q] = (f32x4){0.f, 0.f, 0.f, 0.f};
    for (int k0 = 0; k0 < 32; k0 += 16) {
        f32x4 vv[16];
#pragma unroll
        for (int u = 0; u < 16; ++u) vv[u] = __builtin_nontemporal_load((const f32x4*)(Vg + (size_t)(wid * 32 + k0 + u) * 1024 + 4 * lane));
#pragma unroll
        for (int u = 0; u < 16; ++u) { const int key = wid * 32 + k0 + u; const f32x4 pa = *(const f32x4*)(P + key * 8), pb = *(const f32x4*)(P + key * 8 + 4);
            oa[0] += vv[u] * pa[0]; oa[1] += vv[u] * pa[1]; oa[2] += vv[u] * pa[2]; oa[3] += vv[u] * pa[3];
            oa[4] += vv[u] * pb[0]; oa[5] += vv[u] * pb[1]; oa[6] += vv[u] * pb[2]; oa[7] += vv[u] * pb[3]; }
    }
#pragma unroll
    for (int q = 0; q < 8; ++q) *(f32x4*)(red + (wid * 8 + q) * 256 + 4 * lane) = oa[q];
    lds_barrier();
    { const int q = tid >> 6, d = 4 * (tid & 63); f32x4 s = {0.f, 0.f, 0.f, 0.f};
#pragma unroll
        for (int w = 0; w < 8; ++w) s += *(const f32x4*)(red + (w * 8 + q) * 256 + d);
        const size_t rowb = (size_t)(R0 + q) * PC + h * 256 + d;
        const u32x2 z = *(const u32x2*)(proj + rowb + C_AZ);
        u32x2 o; o.x = pack_bf2(s[0] * __uint_as_float(z.x << 16), s[1] * __uint_as_float(z.x & 0xffff0000u));
        o.y = pack_bf2(s[2] * __uint_as_float(z.y << 16), s[3] * __uint_as_float(z.y & 0xffff0000u));
        if (!dry) *(u32x2*)(proj + rowb + C_Q) = o; }
}

template <int W>
DI void pool_fill_prompt(const bf16_t* proj, bf16_t* As, int R0, int c0, int tid) {
    const int cp = tid & 127, seg = tid >> 7;
    const int col = c0 + 2 * cp, rbase = R0 + seg * 32, pos0 = rbase & 2047;
    unsigned raw[32 + W - 1];
#pragma unroll
    for (int i = 0; i < 32 + W - 1; ++i) { const int o = i - (W - 1); raw[i] = (pos0 + o >= 0) ? *(const unsigned*)(proj + (size_t)(rbase + o) * PC + col) : 0u; }
    float s0 = 0.f, s1 = 0.f;
#pragma unroll
    for (int i = 0; i < W - 1; ++i) { s0 += __uint_as_float(raw[i] << 16); s1 += __uint_as_float(raw[i] & 0xffff0000u); }
#pragma unroll
    for (int i = 0; i < 32; ++i) {
        const unsigned cur = raw[i + W - 1]; const float u0 = __uint_as_float(cur << 16), u1 = __uint_as_float(cur & 0xffff0000u);
        s0 += u0; s1 += u1;
        const int pos = pos0 + i; const float inv = 1.0f / (float)((pos + 1) < W ? (pos + 1) : W);
        *(unsigned*)(As + (seg * 32 + i) * 264 + 2 * cp) = pack_bf2(s0 * inv - u0, s1 * inv - u1);
        s0 -= __uint_as_float(raw[i] << 16); s1 -= __uint_as_float(raw[i] & 0xffff0000u);
    }
}
template <int W>
DI void pool_fill_sample(const Params& p, const bf16_t* proj, bf16_t* As, int R0, int c0, int tid) {
    for (int task = tid; task < 2048; task += 512) {
        const int cp = task & 127, bl = task >> 7; const int col = c0 + 2 * cp, row0 = R0 + bl * 8, bs = (row0 - NPROMPT) >> 3;
        float e0[W + 7], e1[W + 7];
#pragma unroll
        for (int i = 0; i < W - 1; ++i) { const f32x2 sv = *(const f32x2*)(p.in[3] + ((size_t)bs * 15 + 15 - (W - 1) + i) * 1024 + col); e0[i] = sv[0]; e1[i] = sv[1]; }
#pragma unroll
        for (int k = 0; k < 8; ++k) { const unsigned v = *(const unsigned*)(proj + (size_t)(row0 + k) * PC + col); e0[W - 1 + k] = __uint_as_float(v << 16); e1[W - 1 + k] = __uint_as_float(v & 0xffff0000u); }
#pragma unroll
        for (int tl = 0; tl < 8; ++tl) { float s0 = 0.f, s1 = 0.f;
#pragma unroll
            for (int j = 0; j < W; ++j) { s0 += e0[W - 1 + tl - j]; s1 += e1[W - 1 + tl - j]; }
            *(unsigned*)(As + (bl * 8 + tl) * 264 + 2 * cp) = pack_bf2(s0 * (1.0f / W) - e0[W - 1 + tl], s1 * (1.0f / W) - e1[W - 1 + tl]); }
    }
}
DI void pool_item(const Params& p, unsigned char* lds, int item, const int wid_s, const bool dry = false) {
    const int tid = tid_opaque(wid_s), wid = tid >> 6, lane = tid & 63, r = lane & 31, hh = lane >> 5;
    const int rt = item >> 2, g = item & 3;
    bf16_t* proj = (bf16_t*)(p.ws + WS_PROJ);
    bf16_t* As = (bf16_t*)lds;
    const int R0 = rt * 128, c0 = g * 256;
    const bf16_t* wpg = (const bf16_t*)(p.ws + WS_WPG) + (size_t)g * 65536;
    bf16x8 bfrag[16];
#pragma unroll
    for (int kk = 0; kk < 16; ++kk) bfrag[kk] = *(const bf16x8*)(wpg + (size_t)(wid * 32 + r) * 256 + kk * 16 + 8 * hh);
    if (R0 < NPROMPT) {
        if (g == 0) pool_fill_prompt<2>(proj, As, R0, c0, tid); else if (g == 1) pool_fill_prompt<4>(proj, As, R0, c0, tid);
        else if (g == 2) pool_fill_prompt<8>(proj, As, R0, c0, tid); else pool_fill_prompt<16>(proj, As, R0, c0, tid);
    } else {
        if (g == 0) pool_fill_sample<2>(p, proj, As, R0, c0, tid); else if (g == 1) pool_fill_sample<4>(p, proj, As, R0, c0, tid);
        else if (g == 2) pool_fill_sample<8>(p, proj, As, R0, c0, tid); else pool_fill_sample<16>(p, proj, As, R0, c0, tid);
    }
    lds_barrier();
    f32x16 acc[4];
#pragma unroll
    for (int t = 0; t < 4; ++t) for (int i = 0; i < 16; ++i) acc[t][i] = 0.f;
#pragma unroll
    for (int t = 0; t < 4; ++t)
#pragma unroll
        for (int kk = 0; kk < 16; ++kk) { const bf16x8 bd = *(const bf16x8*)(As + (t * 32 + r) * 264 + kk * 16 + 8 * hh); acc[t] = MFMA32(bfrag[kk], bd, acc[t]); }
#pragma unroll
    for (int t = 0; t < 4; ++t) {
        u32x2 zv[4];
#pragma unroll
        for (int gq = 0; gq < 4; ++gq) zv[gq] = *(const u32x2*)(proj + (size_t)(R0 + t * 32 + r) * PC + C_PZ + c0 + wid * 32 + 8 * gq + 4 * hh);
#pragma unroll
        for (int gq = 0; gq < 4; ++gq) { const int ch = c0 + wid * 32 + 8 * gq + 4 * hh; const f32x4 scl = *(const f32x4*)(p.in[11] + ch);
            u32x2 o; o.x = pack_bf2(acc[t][4 * gq] * scl[0] * __uint_as_float(zv[gq].x << 16), acc[t][4 * gq + 1] * scl[1] * __uint_as_float(zv[gq].x & 0xffff0000u));
            o.y = pack_bf2(acc[t][4 * gq + 2] * scl[2] * __uint_as_float(zv[gq].y << 16), acc[t][4 * gq + 3] * scl[3] * __uint_as_float(zv[gq].y & 0xffff0000u));
            if (!dry) *(u32x2*)(proj + (size_t)(R0 + t * 32 + r) * PC + C_PZ + ch) = o; }
    }
}

DI void copy_pass(const Params& p, const int wid_s) {
    const int tid = tid_opaque(wid_s), wid = tid >> 6, lane = tid & 63, G = gridDim.x, bid = blockIdx.x;
    const bf16_t* proj = (const bf16_t*)(p.ws + WS_PROJ);
    for (int chunk = bid * 8 + wid; chunk < 3264; chunk += G * 8) {
        float* dst; const bf16_t* sb = nullptr; const float* sf = nullptr;
        if (chunk < 120) { const int b = chunk / 15, j = chunk % 15; dst = p.out + O_POOLP + (size_t)chunk * 1024; sb = proj + (size_t)(b * 2048 + 2033 + j) * PC + C_PU; }
        else if (chunk < 192) { const int q = chunk - 120, row = q / 3, part = q % 3, b = row / 3, j = row % 3; dst = p.out + O_CONVP + (size_t)row * 3072 + part * 1024; sb = proj + (size_t)(b * 2048 + 2045 + j) * PC + C_XBC + part * 1024; }
        else if (chunk < 2112) { const int q = chunk - 192, b = q / 15, j = q % 15; dst = p.out + O_POOLS + (size_t)q * 1024;
            if (j < 7) sf = p.in[3] + ((size_t)b * 15 + 8 + j) * 1024; else sb = proj + (size_t)(NPROMPT + b * 8 + j - 7) * PC + C_PU; }
        else { const int q = chunk - 2112, row = q / 3, part = q % 3, b = row / 3, j = row % 3; dst = p.out + O_CONVS + (size_t)row * 3072 + part * 1024; sb = proj + (size_t)(NPROMPT + b * 8 + 5 + j) * PC + C_XBC + part * 1024; }
#pragma unroll
        for (int hf = 0; hf < 2; ++hf) { const int e = hf * 512 + lane * 8;
            f32x4 lo, hi;
            if (sf) { lo = *(const f32x4*)(sf + e); hi = *(const f32x4*)(sf + e + 4); }
            else { const u32x4 v = *(const u32x4*)(sb + e);
                lo = (f32x4){__uint_as_float(v.x << 16), __uint_as_float(v.x & 0xffff0000u), __uint_as_float(v.y << 16), __uint_as_float(v.y & 0xffff0000u)};
                hi = (f32x4){__uint_as_float(v.z << 16), __uint_as_float(v.z & 0xffff0000u), __uint_as_float(v.w << 16), __uint_as_float(v.w & 0xffff0000u)}; }
            *(f32x4*)(dst + e) = lo; *(f32x4*)(dst + e + 4) = hi; }
    }
}

DI void copy_item(const Params& p, int item, const int wid_s) {
    const bf16_t* proj = (const bf16_t*)(p.ws + WS_PROJ);
    const int tid = tid_opaque(wid_s);
    const int n0 = 8 * 15 * 1024, n1 = 8 * 3 * 3072, n2 = 128 * 15 * 1024, n3 = 128 * 3 * 3072, total = n0 + n1 + n2 + n3;
    for (int i = item * 512 + tid; i < total; i += 64 * 512) {
        int e = i;
        if (e < n0) { const int b = e / 15360, j = (e / 1024) % 15, c = e & 1023; p.out[O_POOLP + e] = bf2f(proj[(size_t)(b * 2048 + 2033 + j) * PC + C_PU + c]); continue; }
        e -= n0;
        if (e < n1) { const int b = e / 9216, j = (e / 3072) % 3, c = e % 3072; p.out[O_CONVP + e] = bf2f(proj[(size_t)(b * 2048 + 2045 + j) * PC + C_XBC + c]); continue; }
        e -= n1;
        if (e < n2) { const int b = e / 15360, j = (e / 1024) % 15, c = e & 1023;
            p.out[O_POOLS + e] = j < 7 ? p.in[3][((size_t)b * 15 + 8 + j) * 1024 + c] : bf2f(proj[(size_t)(NPROMPT + b * 8 + j - 7) * PC + C_PU + c]); continue; }
        e -= n2;
        { const int b = e / 9216, j = (e / 3072) % 3, c = e % 3072; p.out[O_CONVS + e] = bf2f(proj[(size_t)(NPROMPT + b * 8 + 5 + j) * PC + C_XBC + c]); }
    }
}

constexpr int N_T0 = 256, N_T1 = 256, N_T2 = 544, N_T3 = 512, N_T4 = 512, N_T5 = 64;
constexpr int P2_TOTAL = N_T0 + N_T1 + N_T2 + N_T3 + N_T4 + N_T5;

__global__ void __launch_bounds__(512, 2) mega(Params p) {
    extern __shared__ __attribute__((aligned(16))) unsigned char shm[];
    cg::grid_group grid = cg::this_grid();
    const int wid_s = __builtin_amdgcn_readfirstlane((int)threadIdx.x >> 6);
    const int G = gridDim.x, bid = blockIdx.x;
    unsigned char* ws = p.ws;
    LAS unsigned char* lds3 = (LAS unsigned char*)shm;
    { volatile LAS unsigned* st = (volatile LAS unsigned*)(lds3 + QSLOT_OFF + 16); if (tid_opaque(wid_s) == 0) { st[0] = 0u; st[1] = 0u; } __syncthreads(); }
    const XcdBarrier xb = xcd_barrier_post((unsigned*)(ws + WS_BAR), (volatile LAS unsigned*)(lds3 + QSLOT_OFF + 16), wid_s);

    phase0(p, shm, wid_s);
#if PROBE == 1
    grid.sync(); phase0(p, shm, wid_s);
#endif
    if (p.out == nullptr) grid.sync();
    xcd_barrier(xb, wid_s);

    { SchedP1 S; S.h = (const char*)(ws + WS_H); S.win = (const char*)(ws + WS_WIN); S.mh = (const char*)(ws + WS_MH); S.wkv = (const char*)(ws + WS_WKV); S.G = G; S.c = bid;
      EpiP1 E; E.proj = (bf16_t*)(ws + WS_PROJ); E.out = p.out;
      for (int rep = 0; rep < (PROBE == 2 ? 1 + ONE_RT : 1); ++rep) { if (rep) grid.sync(); gemm_phase(lds3, 1024, 1024, 1024, S, E, wid_s); } }
    xcd_barrier(xb, wid_s);

    bc_conv_pass(p, wid_s);
    copy_pass(p, wid_s);
    xcd_barrier(xb, wid_s);

    { int* qslot = (int*)(shm + QSLOT_OFF);
      unsigned* ctr = (unsigned*)(ws + WS_CTR);
#define P2_LOOP(T, N, CALL) { lds_barrier(); if (tid_opaque(wid_s) == 0) *qslot = (int)atomicAdd(ctr + (T), 1u); lds_barrier();     \
      for (;;) { const int item = *qslot; if (item >= (N)) break; int nxt_ = 0; lds_barrier(); if (tid_opaque(wid_s) == 0) nxt_ = (int)atomicAdd(ctr + (T), 1u); \
        CALL; lds_barrier(); if (tid_opaque(wid_s) == 0) *qslot = nxt_; lds_barrier(); } }
      for (int pass = 0; pass < (PROBE == 3 ? 1 + ONE_RT : 1); ++pass) { __syncthreads(); if (tid_opaque(wid_s) == 0) qslot[1] = pass ? PROBE_LVL : 0; P2_LOOP(0 + 8 * pass, N_T0, ssd_prompt_item(p, shm, item, wid_s)) }
      for (int pass = 0; pass < ((PROBE == 4 || PROBE == 7) ? 1 + ONE_RT : 1); ++pass) P2_LOOP(1 + 8 * pass, N_T1, attn_prompt_item(p, shm, item, wid_s, pass > 0))
      for (int pass = 0; pass < ((PROBE == 4 || PROBE == 8) ? 1 + ONE_RT : 1); ++pass) P2_LOOP(2 + 8 * pass, N_T2, pool_item(p, shm, item, wid_s, pass > 0))
      for (int pass = 0; pass < ((PROBE == 5 || PROBE == 9) ? 1 + ONE_RT : 1); ++pass) P2_LOOP(3 + 8 * pass, N_T3, ssd_sample_item(p, shm, item, wid_s, pass > 0))
      for (int pass = 0; pass < ((PROBE == 5 || PROBE == 10) ? 1 + ONE_RT : 1); ++pass) P2_LOOP(4 + 8 * pass, N_T4, attn_sample_item(p, shm, item, wid_s, pass > 0))
#undef P2_LOOP
    }
    xcd_barrier(xb, wid_s);

    { const int tid = tid_opaque(wid_s), wid = tid >> 6, lane = tid & 63; float* rstd = (float*)(ws + WS_SSQ);
#pragma unroll 2
      for (int row = bid * 8 + wid; row < NTOK; row += G * 8) { const bf16_t* yr = (const bf16_t*)(ws + WS_PROJ) + (size_t)row * PC + C_SZ + lane * 8; float t = 0.f;
#pragma unroll
          for (int j = 0; j < 4; ++j) { const u32x4 v = *(const u32x4*)(yr + j * 512);
#pragma unroll
              for (int e = 0; e < 4; ++e) { const float a = __uint_as_float(v[e] << 16), c2 = __uint_as_float(v[e] & 0xffff0000u); t += a * a + c2 * c2; } }
#pragma unroll
          for (int o = 32; o > 0; o >>= 1) t += __shfl_xor(t, o);
          if (lane == 0) rstd[row] = rsqrtf(t * (1.0f / 2048.0f) + EPS); } }
    { SchedP3 S; S.proj = (const char*)(ws + WS_PROJ); S.wcat = (const char*)(ws + WS_WCAT); S.G = G; S.c = bid;
      EpiP3 E; E.part[0] = (bf16_t*)(ws + WS_H); E.part[1] = (bf16_t*)p.out; E.part[2] = (bf16_t*)p.out + (size_t)NTOK * 1024; E.part[3] = (bf16_t*)(ws + WS_PART3);
      for (int rep = 0; rep < (PROBE == 6 ? 1 + ONE_RT : 1); ++rep) { if (rep) grid.sync(); gemm_phase(lds3, 1024, PC, 4096, S, E, wid_s); } }
    xcd_barrier(xb, wid_s);

    { const int tid = tid_opaque(wid_s);
      bf16_t* p0 = (bf16_t*)(ws + WS_H); const bf16_t* p1 = (const bf16_t*)p.out; const bf16_t* p2 = p1 + (size_t)NTOK * 1024; const bf16_t* p3 = (const bf16_t*)(ws + WS_PART3);
      const bf16_t* proj = (const bf16_t*)(ws + WS_PROJ); const float* ssq = (const float*)(ws + WS_SSQ);
      const size_t n8 = (size_t)NTOK * 128;
#pragma unroll 2
      for (size_t i = (size_t)bid * 512 + tid; i < n8; i += (size_t)G * 512) {
          const size_t row = i >> 7; const int c8 = (int)(i & 127) * 8;
          const float rs = ssq[row];
          const u32x4 a0 = __builtin_nontemporal_load((const u32x4*)(p0 + i * 8)), a1 = __builtin_nontemporal_load((const u32x4*)(p1 + i * 8)), a2 = __builtin_nontemporal_load((const u32x4*)(p2 + i * 8)), a3 = __builtin_nontemporal_load((const u32x4*)(p3 + i * 8));
          const bf16_t* gp = proj + row * PC + C_G + c8;
          const u32x4 g0 = __builtin_nontemporal_load((const u32x4*)gp), g1 = __builtin_nontemporal_load((const u32x4*)(gp + 1024)), g2 = __builtin_nontemporal_load((const u32x4*)(gp + 2048));
          u32x4 o;
#pragma unroll
          for (int j = 0; j < 4; ++j) {
              const float lo = sigmoid_f(__uint_as_float(g0[j] << 16)) * __uint_as_float(a0[j] << 16) + sigmoid_f(__uint_as_float(g1[j] << 16)) * rs * (__uint_as_float(a1[j] << 16) + __uint_as_float(a2[j] << 16)) + sigmoid_f(__uint_as_float(g2[j] << 16)) * __uint_as_float(a3[j] << 16);
              const float hi = sigmoid_f(__uint_as_float(g0[j] & 0xffff0000u)) * __uint_as_float(a0[j] & 0xffff0000u) + sigmoid_f(__uint_as_float(g1[j] & 0xffff0000u)) * rs * (__uint_as_float(a1[j] & 0xffff0000u) + __uint_as_float(a2[j] & 0xffff0000u)) + sigmoid_f(__uint_as_float(g2[j] & 0xffff0000u)) * __uint_as_float(a3[j] & 0xffff0000u);
              o[j] = pack_bf2(lo, hi); }
          *(u32x4*)(p0 + i * 8) = o; } }
    xcd_barrier(xb, wid_s);

    { EpiP4 E; E.out = p.out; E.xp = p.in[0]; E.xs = p.in[1]; E.partq = (float*)(ws + WS_PART3);
      SchedP4 S; S.mg = (const char*)(ws + WS_H); S.wo = (const char*)(ws + WS_WO); S.G = G; S.c = bid;
      for (int rep = 0; rep < (PROBE == 6 ? 1 + ONE_RT : 1); ++rep) { if (rep) grid.sync(); gemm_phase(lds3, 1024, 1024, 1024, S, E, wid_s); } }
    xcd_barrier(xb, wid_s);

    { const int tid = tid_opaque(wid_s), wid = tid >> 6, lane = tid & 63;
#pragma unroll 2
    for (int row = bid * 8 + wid; row < NTOK; row += G * 8) {
        float* o = p.out + (size_t)row * 1024; const float* w = p.in[25];
        f32x4 v[4]; float ss = 0.f;
#pragma unroll
        for (int j = 0; j < 4; ++j) v[j] = __builtin_nontemporal_load((const f32x4*)(o + j * 256 + lane * 4));
        if (row >= 13312) { const float* pq = (const float*)(ws + WS_PART3) + (size_t)(row - 13312) * 256 + lane * 4;
#pragma unroll
            for (int kq = 0; kq < 3; ++kq) v[3] += *(const f32x4*)(pq + (size_t)kq * 4096 * 256); }
#pragma unroll
        for (int j = 0; j < 4; ++j) ss += v[j][0] * v[j][0] + v[j][1] * v[j][1] + v[j][2] * v[j][2] + v[j][3] * v[j][3];
#pragma unroll
        for (int of = 32; of > 0; of >>= 1) ss += __shfl_xor(ss, of);
        const float rs = rsqrtf(ss * (1.0f / 1024.0f) + EPS);
#pragma unroll
        for (int j = 0; j < 4; ++j) { const f32x4 wv = *(const f32x4*)(w + j * 256 + lane * 4); f32x4 r4 = v[j] * rs; r4 *= wv; __builtin_nontemporal_store(r4, (f32x4*)(o + j * 256 + lane * 4)); }
    } }
}

extern "C" void kernel_launch(void* const* d_in, const int* in_sizes, int n_in, void* d_out, int out_size, void* d_ws, size_t ws_size, hipStream_t stream) {
    static int grid_blocks = 0;
    if (grid_blocks == 0) {
        if (n_in != 26 || ws_size < WS_END) { fprintf(stderr, "kernel_launch: unexpected problem shape (n_in %d, ws %zu < %zu)\n", n_in, ws_size, (size_t)WS_END); grid_blocks = -1; return; }
        int dev = 0, cus = 0, per_cu = 0;
        hipGetDevice(&dev);
        hipDeviceGetAttribute(&cus, hipDeviceAttributeMultiprocessorCount, dev);
        if (hipFuncSetAttribute((const void*)mega, hipFuncAttributeMaxDynamicSharedMemorySize, LDS_BYTES) != hipSuccess) { fprintf(stderr, "kernel_launch: hipFuncSetAttribute failed\n"); grid_blocks = -1; return; }
        if (hipOccupancyMaxActiveBlocksPerMultiprocessor(&per_cu, (const void*)mega, 512, LDS_BYTES) != hipSuccess || per_cu < 1) { fprintf(stderr, "kernel_launch: occupancy query says %d\n", per_cu); per_cu = 1; }
        (void)hipGetLastError();
        grid_blocks = cus;
    }
    if (grid_blocks < 0) return;
    (void)hipMemsetAsync((unsigned char*)d_ws + WS_BAR, 0, 16384, stream);
    Params p{};
    for (int i = 0; i < 26; ++i) p.in[i] = (const float*)d_in[i];
    p.out = (float*)d_out; p.ws = (unsigned char*)d_ws;
    void* args[] = {&p};
    hipError_t e = hipLaunchCooperativeKernel((const void*)mega, dim3(grid_blocks), dim3(512), args, LDS_BYTES, stream);
    if (e != hipSuccess) fprintf(stderr, "cooperative launch failed: %s (grid %d)\n", hipGetErrorString(e), grid_blocks);
}
```
